# Optimizing an MI355X kernel written in HIP

```python
import jax, jax.numpy as jnp
from jax import lax
import numpy as np

D_MODEL = 1024
BATCH = 8
SEQ = 2048
DEPTH = 1
DEC_BATCH = 128
DEC_SEQ = 8
PAST_LEN = 16384
PAGE_SIZE = 128

D_CONV = 512
CONV_WIDTH = 31
HG_HEADS = 4
HG_DK = 128
HG_DV = 128
D_HGRN = HG_HEADS * HG_DK
MEM_HEADS = 4
MEM_HEAD_DIM = 128
D_MEM = MEM_HEADS * MEM_HEAD_DIM
N_MEM = 256
N_BRANCH = 3
D_FF = -(-(8 * D_MODEL) // (3 * 256)) * 256
CHUNK = 32
EPS = 1e-6
D_IN = 2 * D_CONV + 4 * D_HGRN + D_MEM + N_BRANCH * D_MODEL

kernel_name = 'gated_conformer_hgrn2_memory_decoder_step'


def _rmsnorm(x, gain):
    xf = x.astype(jnp.float32)
    y = xf * lax.rsqrt(jnp.mean(xf * xf, axis=-1, keepdims=True) + EPS)
    return (y * gain.astype(jnp.float32)).astype(x.dtype)


def _layernorm(x, gain, bias):
    xf = x.astype(jnp.float32)
    mu = jnp.mean(xf, axis=-1, keepdims=True)
    var = jnp.mean(jnp.square(xf - mu), axis=-1, keepdims=True)
    y = (xf - mu) * lax.rsqrt(var + EPS)
    return (y * gain.astype(jnp.float32) + bias.astype(jnp.float32)).astype(x.dtype)


def _causal_dwconv(u_ext, conv_w, conv_b):
    out = lax.conv_general_dilated(
        u_ext, conv_w[:, None, :].astype(u_ext.dtype), window_strides=(1,), padding='VALID',
        dimension_numbers=('NWC', 'WIO', 'NWC'), feature_group_count=u_ext.shape[-1])
    return out + conv_b.astype(out.dtype)


def _hgrn2_chunkwise(q, k, v, logf, s0):
    B, L = q.shape[0], q.shape[1]
    n_chunks = -(-L // CHUNK)
    pad = n_chunks * CHUNK - L

    def prep(t):
        t = jnp.pad(t, ((0, 0), (0, pad), (0, 0), (0, 0)))
        return t.reshape((B, n_chunks, CHUNK) + t.shape[2:])

    q, k, v, logf = prep(q), prep(k), prep(v), prep(logf)
    b = jnp.cumsum(logf, axis=2)
    b_last = b[:, :, -1:]
    q_dec = q * jnp.exp(b)
    k_inv = k * jnp.exp(-b)
    k_end = k * jnp.exp(b_last - b)
    causal = jnp.tril(jnp.ones((CHUNK, CHUNK), dtype=bool))
    scores = jnp.where(causal, jnp.einsum('bnthd,bnshd->bnhts', q_dec, k_inv), 0.0)
    o_intra = jnp.einsum('bnhts,bnshv->bnthv', scores, v)
    chunk_kv = jnp.einsum('bnshd,bnshv->bnhdv', k_end, v)
    decay = jnp.exp(b[:, :, -1])

    def step(S, xs):
        qd, dec, kv = xs
        o = jnp.einsum('bthd,bhdv->bthv', qd, S)
        S = dec[..., None] * S + kv
        return S, o

    xs = (jnp.moveaxis(q_dec, 1, 0), jnp.moveaxis(decay, 1, 0), jnp.moveaxis(chunk_kv, 1, 0))
    s_final, o_inter = lax.scan(step, s0, xs)
    o = o_intra + jnp.moveaxis(o_inter, 0, 1)
    o = o.reshape((B, n_chunks * CHUNK) + o.shape[3:])[:, :L]
    return o, s_final


def _memory_kv(mem, mem_norm_g, w_mem_kv):
    m = _rmsnorm(mem, mem_norm_g)
    kv = jnp.einsum('bmd,de->bme', m, w_mem_kv)
    k, v = jnp.split(kv, 2, axis=-1)
    shp = (mem.shape[0], mem.shape[1], MEM_HEADS, MEM_HEAD_DIM)
    return k.reshape(shp), v.reshape(shp)


def _mixer(h, conv_prefix, hg_state, mem_k, mem_v, lb, w_in, conv_w, conv_b, conv_ln_g, conv_ln_b,
           w_conv_out, hg_norm_g, w_hg_out, w_mem_out, w_out):
    B, L, _ = h.shape
    z = jnp.einsum('bld,de->ble', h, w_in)
    sizes = (D_CONV, D_CONV, D_HGRN, D_HGRN, D_HGRN, D_HGRN, D_MEM)
    idx = [int(i) for i in np.cumsum(sizes)]
    ca, cb, hq, hf, hi, hgate, mq, gl = jnp.split(z, idx, axis=-1)

    u = ca * jax.nn.sigmoid(cb)
    u_ext = jnp.concatenate([conv_prefix.astype(u.dtype), u], axis=1)
    c = _causal_dwconv(u_ext, conv_w, conv_b)
    c = jax.nn.silu(_layernorm(c, conv_ln_g, conv_ln_b))
    p_conv = jnp.einsum('blc,cd->bld', c, w_conv_out)
    new_conv = u_ext[:, u_ext.shape[1] - (CONV_WIDTH - 1):]

    fx = hf.astype(jnp.float32).reshape(B, L, HG_HEADS, HG_DK)
    lbh = lb.reshape(HG_HEADS, HG_DK)
    logf = jnp.log(lbh + (1.0 - lbh) * jax.nn.sigmoid(fx))
    k = (1.0 - lbh) * jax.nn.sigmoid(-fx)
    q = jax.nn.silu(hq.astype(jnp.float32)).reshape(B, L, HG_HEADS, HG_DK)
    v = hi.astype(jnp.float32).reshape(B, L, HG_HEADS, HG_DV)
    o, new_hg = _hgrn2_chunkwise(q, k, v, logf, hg_state.astype(jnp.float32))
    o = _rmsnorm(o, hg_norm_g).astype(h.dtype).reshape(B, L, D_HGRN) * jax.nn.silu(hgate)
    p_hg = jnp.einsum('ble,ed->bld', o, w_hg_out)

    qm = mq.reshape(B, L, MEM_HEADS, MEM_HEAD_DIM)
    s = jnp.einsum('blhd,bmhd->bhlm', qm, mem_k).astype(jnp.float32) * (MEM_HEAD_DIM ** -0.5)
    p = jax.nn.softmax(s, axis=-1).astype(mem_v.dtype)
    om = jnp.einsum('bhlm,bmhd->blhd', p, mem_v).reshape(B, L, D_MEM)
    p_mem = jnp.einsum('ble,ed->bld', om, w_mem_out)

    g = jax.nn.sigmoid(gl.reshape(B, L, N_BRANCH, D_MODEL))
    merged = g[:, :, 0] * p_conv + g[:, :, 1] * p_hg + g[:, :, 2] * p_mem
    out = jnp.einsum('bld,de->ble', merged, w_out)
    return out, new_conv, new_hg.astype(hg_state.dtype)


def _layer(x, conv_prefix, hg_state, mem_k, mem_v, lb, norm_pre_mix, norm_post_mix, norm_pre_ffn,
           norm_post_ffn, w_in, conv_w, conv_b, conv_ln_g, conv_ln_b, w_conv_out, hg_norm_g, w_hg_out,
           w_mem_out, w_out, w_ffn_gate, w_ffn_up, w_ffn_down):
    h = _rmsnorm(x, norm_pre_mix)
    m, new_conv, new_hg = _mixer(h, conv_prefix, hg_state, mem_k, mem_v, lb, w_in, conv_w, conv_b,
                                 conv_ln_g, conv_ln_b, w_conv_out, hg_norm_g, w_hg_out, w_mem_out, w_out)
    x = x + _rmsnorm(m, norm_post_mix)
    h = _rmsnorm(x, norm_pre_ffn)
    f = jax.nn.silu(jnp.einsum('bld,df->blf', h, w_ffn_gate)) * jnp.einsum('bld,df->blf', h, w_ffn_up)
    f = jnp.einsum('blf,fd->bld', f, w_ffn_down)
    x = x + _rmsnorm(f, norm_post_ffn)
    return x, new_conv, new_hg


def setup_inputs(seed: int = 0) -> dict:
    key = jax.random.key(seed)
    ks = iter(jax.random.split(key, 32))

    def nrm(shape, scale):
        return jax.random.normal(next(ks), shape, jnp.float32) * scale

    def gain(shape):
        return 1.0 + nrm(shape, 0.02)

    return {
        'x_prompt': nrm((BATCH, SEQ, D_MODEL), 1.0),
        'x_sample': nrm((DEC_BATCH, DEC_SEQ, D_MODEL), 1.0),
        'mem_prompt': nrm((BATCH, N_MEM, D_MODEL), 1.0),
        'state_conv': nrm((DEPTH, DEC_BATCH, CONV_WIDTH - 1, D_CONV), 0.5),
        'state_hgrn': nrm((DEPTH, DEC_BATCH, HG_HEADS, HG_DK, HG_DV), 0.3),
        'cache_mem_k': nrm((DEPTH, DEC_BATCH, N_MEM, MEM_HEADS, MEM_HEAD_DIM), 1.0),
        'cache_mem_v': nrm((DEPTH, DEC_BATCH, N_MEM, MEM_HEADS, MEM_HEAD_DIM), 1.0),
        'norm_pre_mix': gain((DEPTH, D_MODEL)),
        'norm_post_mix': gain((DEPTH, D_MODEL)),
        'norm_pre_ffn': gain((DEPTH, D_MODEL)),
        'norm_post_ffn': gain((DEPTH, D_MODEL)),
        'w_in': nrm((DEPTH, D_MODEL, D_IN), D_MODEL ** -0.5),
        'conv_w': nrm((DEPTH, CONV_WIDTH, D_CONV), CONV_WIDTH ** -0.5),
        'conv_b': nrm((DEPTH, D_CONV), 0.02),
        'conv_ln_g': gain((DEPTH, D_CONV)),
        'conv_ln_b': nrm((DEPTH, D_CONV), 0.02),
        'w_conv_out': nrm((DEPTH, D_CONV, D_MODEL), D_CONV ** -0.5),
        'hg_lb_logits': nrm((DEPTH + 1, D_HGRN), 0.5),
        'hg_norm_g': gain((DEPTH, HG_DV)),
        'w_hg_out': nrm((DEPTH, D_HGRN, D_MODEL), D_HGRN ** -0.5),
        'mem_norm_g': gain((DEPTH, D_MODEL)),
        'w_mem_kv': nrm((DEPTH, D_MODEL, 2 * D_MEM), D_MODEL ** -0.5),
        'w_mem_out': nrm((DEPTH, D_MEM, D_MODEL), D_MEM ** -0.5),
        'w_out': nrm((DEPTH, D_MODEL, D_MODEL), D_MODEL ** -0.5),
        'w_ffn_gate': nrm((DEPTH, D_MODEL, D_FF), D_MODEL ** -0.5),
        'w_ffn_up': nrm((DEPTH, D_MODEL, D_FF), D_MODEL ** -0.5),
        'w_ffn_down': nrm((DEPTH, D_FF, D_MODEL), D_FF ** -0.5),
    }


def reference(x_prompt, x_sample, mem_prompt, state_conv, state_hgrn, cache_mem_k, cache_mem_v,
              norm_pre_mix, norm_post_mix, norm_pre_ffn, norm_post_ffn, w_in, conv_w, conv_b,
              conv_ln_g, conv_ln_b, w_conv_out, hg_lb_logits, hg_norm_g, w_hg_out, mem_norm_g,
              w_mem_kv, w_mem_out, w_out, w_ffn_gate, w_ffn_up, w_ffn_down):
    lb_all = jnp.cumsum(jax.nn.softmax(hg_lb_logits.astype(jnp.float32), axis=0), axis=0)
    xp, xs = x_prompt, x_sample
    conv_p, hg_p, mk_p, mv_p, conv_s, hg_s = [], [], [], [], [], []
    for l in range(DEPTH):
        shared = (norm_pre_mix[l], norm_post_mix[l], norm_pre_ffn[l], norm_post_ffn[l], w_in[l],
                  conv_w[l], conv_b[l], conv_ln_g[l], conv_ln_b[l], w_conv_out[l], hg_norm_g[l],
                  w_hg_out[l], w_mem_out[l], w_out[l], w_ffn_gate[l], w_ffn_up[l], w_ffn_down[l])
        lb = lb_all[l]
        mk, mv = _memory_kv(mem_prompt, mem_norm_g[l], w_mem_kv[l])
        prefix0 = jnp.zeros((xp.shape[0], CONV_WIDTH - 1, D_CONV), xp.dtype)
        s00 = jnp.zeros((xp.shape[0], HG_HEADS, HG_DK, HG_DV), xp.dtype)
        xp, nc_p, nh_p = _layer(xp, prefix0, s00, mk, mv, lb, *shared)
        xs, nc_s, nh_s = _layer(xs, state_conv[l], state_hgrn[l], cache_mem_k[l], cache_mem_v[l], lb, *shared)
        conv_p.append(nc_p)
        hg_p.append(nh_p)
        mk_p.append(mk)
        mv_p.append(mv)
        conv_s.append(nc_s)
        hg_s.append(nh_s)
    return (xp, xs, jnp.stack(conv_p), jnp.stack(hg_p), jnp.stack(mk_p), jnp.stack(mv_p),
            jnp.stack(conv_s), jnp.stack(hg_s))
```

```cpp
#include <hip/hip_runtime.h>
#include <hip/hip_cooperative_groups.h>
#include <cstdio>
#include <cstdint>
namespace cg = cooperative_groups;
#ifndef REP_G
#define REP_G 1
#endif
#ifndef REP_M
#define REP_M 1
#endif
#ifndef REP_P0
#define REP_P0 1
#endif
#ifndef REP_C
#define REP_C 1
#endif
#ifndef HG1_END
#define HG1_END 2560
#endif

#define LAS __attribute__((address_space(3)))
typedef unsigned short bf16_t;
typedef short bf16x8 __attribute__((ext_vector_type(8)));
typedef float f32x4 __attribute__((ext_vector_type(4)));
typedef float f32x2 __attribute__((ext_vector_type(2)));
typedef unsigned u32x4 __attribute__((ext_vector_type(4)));
typedef unsigned u32x2 __attribute__((ext_vector_type(2)));

constexpr int DM = 1024, MP = 16384, MS = 1024, MT = MP + MS, DIN = 6656, DFF = 2816, NPROJ = 3584, NGATE = 3072;
constexpr int NMEMROWS = 2048;
constexpr float EPS = 1e-6f;
constexpr int LDS_BYTES = 131072 + 64;

constexpr size_t SZ_ACT512 = (size_t)MT * 512 * 2;
constexpr size_t SZ_ACT1024 = (size_t)MT * 1024 * 2;
constexpr size_t WS_WIN = 0;
constexpr size_t WS_W3 = WS_WIN + (size_t)DIN * 1024 * 2;
constexpr size_t WS_WO = WS_W3 + (size_t)3072 * 512 * 2;
constexpr size_t WS_WGU = WS_WO + (size_t)1024 * 1024 * 2;
constexpr size_t WS_WD = WS_WGU + (size_t)2 * DFF * 1024 * 2;
constexpr size_t WS_WKV = WS_WD + (size_t)1024 * DFF * 2;
constexpr size_t WS_XN = WS_WKV + (size_t)1024 * 1024 * 2;
constexpr size_t WS_KB = WS_XN + SZ_ACT1024;
constexpr size_t WS_VT = WS_KB + SZ_ACT1024;
constexpr size_t WS_U = WS_VT + SZ_ACT1024;
constexpr size_t WS_QD = WS_U + SZ_ACT512;
constexpr size_t WS_KI = WS_QD + SZ_ACT512;
constexpr size_t WS_VV = WS_KI + SZ_ACT512;
constexpr size_t WS_HGT = WS_VV + SZ_ACT512;
constexpr size_t WS_MQ = WS_HGT + SZ_ACT512;
constexpr size_t WS_C = WS_MQ + SZ_ACT512;
constexpr size_t WS_KE = WS_C + SZ_ACT512;
constexpr size_t WS_OM = WS_KE + SZ_ACT512;
constexpr size_t WS_DEC = WS_OM + SZ_ACT512;
constexpr size_t WS_MN = WS_DEC + (size_t)2560 * 128 * 4;
constexpr size_t WS_PART = WS_MN + (size_t)NMEMROWS * 1024 * 2;
constexpr size_t WS_BAR = WS_PART + (size_t)4 * 1024 * 1024 * 4;
constexpr size_t WS_END = WS_BAR + 16384;

constexpr size_t O_Y = 0;
constexpr size_t O_CONVP = (size_t)MT * 1024;
constexpr size_t O_HGP = O_CONVP + 8 * 30 * 512;
constexpr size_t O_MK = O_HGP + 8 * 4 * 128 * 128;
constexpr size_t O_MV = O_MK + 8 * 256 * 512;
constexpr size_t O_CONVS = O_MV + 8 * 256 * 512;
constexpr size_t O_HGS = O_CONVS + 128 * 30 * 512;

struct Params {
    const float *x_prompt, *x_sample, *mem_prompt, *state_conv, *state_hgrn, *cache_k, *cache_v;
    const float *g_pre_mix, *g_post_mix, *g_pre_ffn, *g_post_ffn;
    const float *w_in, *conv_w, *conv_b, *ln_g, *ln_b, *w_conv_out, *lb_logits, *hg_norm_g, *w_hg_out, *mem_norm_g, *w_mem_kv, *w_mem_out, *w_out, *w_gate, *w_up, *w_down;
    float* out;
    unsigned char* ws;
};

typedef __bf16 bf16x2_t __attribute__((ext_vector_type(2)));
__device__ __forceinline__ unsigned pk2(float lo, float hi) { f32x2 v = {lo, hi}; bf16x2_t b = __builtin_convertvector(v, bf16x2_t); return __builtin_bit_cast(unsigned, b); }
__device__ __forceinline__ float bf_lo(unsigned u) { return __uint_as_float(u << 16); }
__device__ __forceinline__ float bf_hi(unsigned u) { return __uint_as_float(u & 0xffff0000u); }
__device__ __forceinline__ float bf2f(bf16_t h) { return __uint_as_float((unsigned)h << 16); }
__device__ __forceinline__ float sigm(float x) { return __builtin_amdgcn_rcpf(1.f + __expf(-x)); }
__device__ __forceinline__ float silu(float x) { return x * sigm(x); }
__device__ __forceinline__ float wave_sum(float v) {
    v += __int_as_float(__builtin_amdgcn_update_dpp(0, __float_as_int(v), 0x111, 0xf, 0xf, false));
    v += __int_as_float(__builtin_amdgcn_update_dpp(0, __float_as_int(v), 0x112, 0xf, 0xf, false));
    v += __int_as_float(__builtin_amdgcn_update_dpp(0, __float_as_int(v), 0x114, 0xf, 0xf, false));
    v += __int_as_float(__builtin_amdgcn_update_dpp(0, __float_as_int(v), 0x118, 0xf, 0xf, false));
    v += __int_as_float(__builtin_amdgcn_update_dpp(0, __float_as_int(v), 0x142, 0xa, 0xf, false));
    v += __int_as_float(__builtin_amdgcn_update_dpp(0, __float_as_int(v), 0x143, 0xc, 0xf, false));
    return __int_as_float(__builtin_amdgcn_readlane(__float_as_int(v), 63));
}
#define LDS_WAIT() asm volatile("s_waitcnt lgkmcnt(0)" ::: "memory")

namespace pg8 {
constexpr int BM = 256, BK = 64, HALF = 128, HTB = HALF * BK * 2, STAGE_BYTES = 8 * HTB, NXCD = 8, WGM = 8;
__device__ __forceinline__ int lds_byte(int r, int c) { const int st = (r >> 4) * 2 + (c >> 5), rr = r & 15, cc = c & 31, ob = rr * 64 + cc * 2; return st * 1024 + (ob ^ (((ob >> 9) & 1) << 5)); }
__device__ __forceinline__ void stage_rc(int b, int& R, int& C) { const int st = b / 1024, sb = b % 1024, swz = sb ^ (((sb >> 9) & 1) << 5); R = (st >> 1) * 16 + swz / 64; C = (st & 1) * 32 + (swz % 64) / 2; }
__device__ __forceinline__ int perm32(int rho) { const int n = rho >> 4, i = rho & 15; return 8 * (i >> 2) + 4 * n + (i & 3); }

struct Unit { int pm, pn, br, job, k0, nt, part; };

__device__ __forceinline__ void tile_map(int L, int nM, int nN, int& pm, int& pn) {
    const int nwg = nM * nN;
    int wgid = L; { const int q = nwg / NXCD, r = nwg % NXCD, xcd = wgid % NXCD, off = wgid / NXCD; wgid = (xcd < r ? xcd * (q + 1) : r * (q + 1) + (xcd - r) * q) + off; }
    const int nig = WGM * nN, gid = wgid / nig, fm = gid * WGM, gsz = (nM - fm) < WGM ? (nM - fm) : WGM;
    pm = fm + ((wgid % nig) % gsz); pn = (wgid % nig) / gsz;
}
struct Sched {
    const char *A0, *B0;
    long dAj, dBj, dAb, dBb;
    int nM0, nN0, nt0, nM1, nN1, nt1, nbr, G, c;
    int ktiles, split, nta, ntb;
    size_t tstep;
    __device__ __forceinline__ bool next(int i, Unit& u) const {
        u.k0 = 0; u.nt = ktiles; u.part = 0;
        if (split) {
            long Ls = (long)i * G + c;
            if (Ls < nt0) { tile_map((int)Ls, nM0, nN0, u.pm, u.pn); u.br = 0; u.job = 0; return true; }
            Ls -= nt0;
            if (Ls < 64) { const int tile = (int)Ls >> 2, part = (int)Ls & 3; u.pm = 64 + (tile >> 2); u.pn = tile & 3; u.br = 0; u.job = 1; u.part = part;
                u.k0 = part < 2 ? part * nta : 2 * nta + (part - 2) * ntb; u.nt = part < 2 ? nta : ntb; return true; }
            return false;
        }
        int ii = i / nbr; const int br = i - ii * nbr;
        if (REP_G > 1) { const int nloc = (nt0 + nt1 - c + G - 1) / G; const int pass = ii / nloc; if (pass >= REP_G) return false; ii -= pass * nloc; }
        long L = (long)ii * G + c;
        if (L < nt0) { tile_map((int)L, nM0, nN0, u.pm, u.pn); u.br = br; u.job = 0; return true; }
        L -= nt0;
        if (L < nt1) { tile_map((int)L, nM1, nN1, u.pm, u.pn); u.br = 0; u.job = 1; return true; }
        return false;
    }
    __device__ __forceinline__ const char* a_base(const Unit& u) const { return A0 + (long)u.job * dAj + (long)u.br * dAb + (size_t)u.pm * tstep + (size_t)u.k0 * (BK * 2); }
    __device__ __forceinline__ const char* b_base(const Unit& u) const { return B0 + (long)u.job * dBj + (long)u.br * dBb + (size_t)u.pn * tstep + (size_t)u.k0 * (BK * 2); }
};

template <class Epi, bool KEEP = false>
__device__ __forceinline__ void gemm_phase(LAS unsigned char* lds, const int K, const Sched& S, const Epi& E) {
    int tid_ = threadIdx.x; asm volatile("" : "+v"(tid_));
    const int tid = tid_, wid = __builtin_amdgcn_readfirstlane(tid >> 6), lane = tid & 63, wr = wid >> 2, wc = wid & 3, fr = lane & 15, fq = lane >> 4;
    unsigned voffA[2], voffB[2];
#pragma unroll
    for (int i = 0; i < 2; ++i) { int R, C; stage_rc(tid * 16 + i * 8192, R, C); const int Rb = (R & ~31) + perm32(R & 31);
        voffA[i] = (unsigned)(R * K + C) * 2u; voffB[i] = (unsigned)(Rb * K + C) * 2u; }
    const size_t kstep = (size_t)(BK * 2);
    const size_t hstep = (size_t)HALF * K * 2;
    const unsigned ldsw = (unsigned)wid * 1024u;
    const int aoff = lds_byte(wr * 64 + fr, fq * 8), boff = lds_byte(wc * 32 + fr, fq * 8);
#define PG8_SA(b, h) (((b) * 2 + (h)) * HTB)
#define PG8_SB(b, h) ((4 + (b) * 2 + (h)) * HTB)
#define PG8_STAGE(bufoff, gbase, voff) do { _Pragma("unroll") for (int _i = 0; _i < 2; ++_i) \
        __builtin_amdgcn_global_load_lds((const unsigned*)((const char*)(gbase) + (voff)[_i]), (LAS unsigned*)(lds + (bufoff) + ldsw + _i * 8192), 16, 0, 0); } while (0)
#define PG8_LDA(dst, b, h) do { _Pragma("unroll") for (int m = 0; m < 4; ++m) _Pragma("unroll") for (int k = 0; k < 2; ++k) dst[m][k] = *(const LAS bf16x8*)(lds + PG8_SA(b, h) + aoff + m * 2048 + k * 1024); } while (0)
#define PG8_LDB(dst, b, h) do { _Pragma("unroll") for (int n = 0; n < 2; ++n) _Pragma("unroll") for (int k = 0; k < 2; ++k) dst[n][k] = *(const LAS bf16x8*)(lds + PG8_SB(b, h) + boff + n * 2048 + k * 1024); } while (0)
#define PG8_MMA(ai, bj, At, Bt) do { __builtin_amdgcn_s_setprio(1); _Pragma("unroll") for (int m = 0; m < 4; ++m) _Pragma("unroll") for (int n = 0; n < 2; ++n) _Pragma("unroll") for (int k = 0; k < 2; ++k) \
        acc[ai][bj][m][n] = __builtin_amdgcn_mfma_f32_16x16x32_bf16(Bt[n][k], At[m][k], acc[ai][bj][m][n], 0, 0, 0); __builtin_amdgcn_s_setprio(0); } while (0)
#define PG8_WAIT_V(n) asm volatile("s_waitcnt vmcnt(" #n ")" ::: "memory")
#define PG8_WAIT_L(n) asm volatile("s_waitcnt lgkmcnt(" #n ")" ::: "memory")
#define PG8_BAR __builtin_amdgcn_s_barrier()
#define PG8_SCHED __builtin_amdgcn_sched_barrier(0)
    Unit cur, nxt; int ui = 0;
    if (!S.next(0, cur)) return;
    f32x4 acc[2][2][4][2];
#pragma unroll
    for (int a = 0; a < 2; ++a)
#pragma unroll
        for (int b = 0; b < 2; ++b)
#pragma unroll
            for (int m = 0; m < 4; ++m)
#pragma unroll
                for (int n = 0; n < 2; ++n) acc[a][b][m][n] = (f32x4){0.f, 0.f, 0.f, 0.f};
    bf16x8 At[4][2], B0[2][2], B1[2][2];
    const char* cA = S.a_base(cur); const char* cB = S.b_base(cur);
    PG8_STAGE(PG8_SB(0, 0), cB, voffB); PG8_STAGE(PG8_SA(0, 0), cA, voffA); PG8_STAGE(PG8_SB(0, 1), cB + hstep, voffB); PG8_STAGE(PG8_SA(0, 1), cA + hstep, voffA);
    if (wr == 1) PG8_BAR;
    PG8_WAIT_V(4); PG8_BAR;
    PG8_STAGE(PG8_SB(1, 0), cB + kstep, voffB); PG8_STAGE(PG8_SA(1, 0), cA + kstep, voffA); PG8_STAGE(PG8_SB(1, 1), cB + hstep + kstep, voffB);
    PG8_WAIT_V(6); PG8_BAR;
    for (;;) {
        const bool has_next = S.next(ui + 1, nxt);
        const char* nA = has_next ? S.a_base(nxt) : cA; const char* nB = has_next ? S.b_base(nxt) : cB;
        const int nt = cur.nt;
        for (int t = 0; t < nt; t += 2) {
            const bool last = (t == nt - 2);
            const char* a1 = cA + (size_t)(t + 1) * kstep;
            const char* a2 = last ? nA : cA + (size_t)(t + 2) * kstep; const char* b2 = last ? nB : cB + (size_t)(t + 2) * kstep;
            const char* a3 = a2 + kstep; const char* b3 = b2 + kstep;
            PG8_LDB(B0, 0, 0); PG8_SCHED; PG8_LDA(At, 0, 0); PG8_STAGE(PG8_SA(1, 1), a1 + hstep, voffA);
            PG8_WAIT_L(8); PG8_BAR; PG8_WAIT_L(0); PG8_MMA(0, 0, At, B0); PG8_BAR; PG8_SCHED;
            PG8_LDB(B1, 0, 1); PG8_STAGE(PG8_SB(0, 0), b2, voffB);
            PG8_BAR; PG8_WAIT_L(0); PG8_MMA(0, 1, At, B1); PG8_BAR;
            PG8_LDA(At, 0, 1); PG8_STAGE(PG8_SA(0, 0), a2, voffA);
            PG8_BAR; PG8_WAIT_L(0); PG8_MMA(1, 0, At, B0); PG8_BAR; PG8_SCHED;
            PG8_STAGE(PG8_SB(0, 1), b2 + hstep, voffB);
            PG8_WAIT_V(6); PG8_BAR; PG8_MMA(1, 1, At, B1); PG8_BAR;
            PG8_LDB(B0, 1, 0); PG8_SCHED; PG8_LDA(At, 1, 0); PG8_STAGE(PG8_SA(0, 1), a2 + hstep, voffA);
            PG8_WAIT_L(8); PG8_BAR; PG8_WAIT_L(0); PG8_MMA(0, 0, At, B0); PG8_BAR; PG8_SCHED;
            PG8_LDB(B1, 1, 1); PG8_STAGE(PG8_SB(1, 0), b3, voffB);
            PG8_BAR; PG8_WAIT_L(0); PG8_MMA(0, 1, At, B1); PG8_BAR;
            PG8_LDA(At, 1, 1); PG8_STAGE(PG8_SA(1, 0), a3, voffA);
            PG8_BAR; PG8_WAIT_L(0); PG8_MMA(1, 0, At, B0); PG8_BAR; PG8_SCHED;
            PG8_STAGE(PG8_SB(1, 1), b3 + hstep, voffB);
            PG8_WAIT_V(6); PG8_BAR; PG8_MMA(1, 1, At, B1); PG8_BAR;
        }
        bool clear = true;
        if constexpr (KEEP) { E.merge(acc, cur, wr, wc, fr, fq); clear = (cur.br == 2); } else E(acc, cur, wr, wc, fr, fq);
        if (!has_next) break;
        if (clear)
#pragma unroll
        for (int a = 0; a < 2; ++a)
#pragma unroll
            for (int b = 0; b < 2; ++b)
#pragma unroll
                for (int m = 0; m < 4; ++m)
#pragma unroll
                    for (int n = 0; n < 2; ++n) acc[a][b][m][n] = (f32x4){0.f, 0.f, 0.f, 0.f};
        cur = nxt; cA = nA; cB = nB; ++ui;
    }
    PG8_WAIT_V(0);
    if (wr == 0) PG8_BAR;
    PG8_BAR;
#undef PG8_SA
#undef PG8_SB
#undef PG8_STAGE
#undef PG8_LDA
#undef PG8_LDB
#undef PG8_MMA
#undef PG8_WAIT_V
#undef PG8_WAIT_L
#undef PG8_BAR
#undef PG8_SCHED
}
}
using pg8::Unit;
typedef f32x4 Acc[2][2][4][2];

template <int ACT>
__device__ __forceinline__ void store_plain(const Acc& acc, bf16_t* O, int ldc, int row0, int col0, float scale) {
#pragma unroll
    for (int ai = 0; ai < 2; ++ai)
#pragma unroll
        for (int m = 0; m < 4; ++m) {
            bf16_t* rowp = O + (size_t)(row0 + ai * 128 + m * 16) * ldc + col0;
#pragma unroll
            for (int bj = 0; bj < 2; ++bj) {
                float v[8];
#pragma unroll
                for (int n = 0; n < 2; ++n)
#pragma unroll
                    for (int i = 0; i < 4; ++i) { float x = acc[ai][bj][m][n][i]; if (ACT == 1) x = silu(x); else if (ACT == 2) x *= scale; else if (ACT == 3) x = fmaxf(sigm(x), 1e-30f); v[4 * n + i] = x; }
                u32x4 o; o.x = pk2(v[0], v[1]); o.y = pk2(v[2], v[3]); o.z = pk2(v[4], v[5]); o.w = pk2(v[6], v[7]);
                *(u32x4*)(rowp + bj * 128) = o;
            }
        }
}

struct EpiP1 {
    bf16_t *U, *QD, *KI, *KE, *VV, *HGT, *MQ, *KB, *VT;
    float *DEC, *mk, *mv;
    const float* lbl;
    __device__ __forceinline__ void operator()(const Acc& acc, const Unit& u, int wr, int wc, int fr, int fq) const {
        const int rowb = u.pm * 256 + wr * 64 + fr, cl = wc * 32 + 8 * fq;
        if (u.job == 1) {
            const int b = u.pm;
#pragma unroll
            for (int ai = 0; ai < 2; ++ai)
#pragma unroll
                for (int m = 0; m < 4; ++m) {
                    const int key = ai * 128 + wr * 64 + m * 16 + fr, row = b * 256 + key;
#pragma unroll
                    for (int bj = 0; bj < 2; ++bj) {
                        const f32x4 v0 = acc[ai][bj][m][0], v1 = acc[ai][bj][m][1];
                        if (u.pn < 2) {
                            const int h = 2 * u.pn + bj, c = h * 128 + cl;
                            float* o = mk + (size_t)row * 512 + c; *(f32x4*)o = v0; *(f32x4*)(o + 4) = v1;
                            u32x4 pk; pk.x = pk2(v0[0], v0[1]); pk.y = pk2(v0[2], v0[3]); pk.z = pk2(v1[0], v1[1]); pk.w = pk2(v1[2], v1[3]);
                            *(u32x4*)(KB + ((size_t)((b * 4 + h) * 256 + key)) * 128 + cl) = pk;
                        } else {
                            const int h = 2 * (u.pn - 2) + bj, c = h * 128 + cl;
                            float* o = mv + (size_t)row * 512 + c; *(f32x4*)o = v0; *(f32x4*)(o + 4) = v1;
                            const int ko = key & 31, kp = (key & ~31) + ((ko & 15) >> 2) * 8 + (ko & 3) + ((ko >> 4) << 2);
                            bf16_t* vt = VT + ((size_t)((b * 4 + h) * 128 + cl)) * 256 + kp;
#pragma unroll
                            for (int i = 0; i < 4; ++i) { vt[(size_t)i * 256] = (bf16_t)(pk2(v0[i], 0.f) & 0xffffu); vt[(size_t)(4 + i) * 256] = (bf16_t)(pk2(v1[i], 0.f) & 0xffffu); }
                        }
                    }
                }
            return;
        }
        const int pn = u.pn;
        if (pn < 4) {
#pragma unroll
            for (int ai = 0; ai < 2; ++ai)
#pragma unroll
                for (int m = 0; m < 4; ++m) {
                    float v[8];
#pragma unroll
                    for (int n = 0; n < 2; ++n)
#pragma unroll
                        for (int i = 0; i < 4; ++i) v[4 * n + i] = acc[ai][0][m][n][i] * sigm(acc[ai][1][m][n][i]);
                    u32x4 o; o.x = pk2(v[0], v[1]); o.y = pk2(v[2], v[3]); o.z = pk2(v[4], v[5]); o.w = pk2(v[6], v[7]);
                    *(u32x4*)(U + (size_t)(rowb + ai * 128 + m * 16) * 512 + pn * 128 + cl) = o;
                }
        } else if (pn < 8) {
            const int h = pn - 4;
            const bool isP = u.pm < 64;
            const int segm = isP ? 15 : 7;
#pragma unroll
            for (int ai = 0; ai < 2; ++ai)
#pragma unroll
                for (int mm = 0; mm < 2; ++mm)
#pragma unroll
                    for (int n = 0; n < 2; ++n) {
                        const int cc = h * 128 + cl + 4 * n;
                        const f32x4 l0 = *(const f32x4*)(lbl + cc), l1 = *(const f32x4*)(lbl + 512 + cc);
                        float qd[2][4], ki[2][4], ke[2][4], dc[2][4];
#pragma unroll
                        for (int i = 0; i < 4; ++i) {
                            const float lb = sigm(l0[i] - l1[i]);
                            float bb[2], kk[2];
#pragma unroll
                            for (int mi = 0; mi < 2; ++mi) {
                                const float fx = acc[ai][1][2 * mm + mi][n][i];
                                const float sg = sigm(fx);
                                float x = __logf(lb + (1.f - lb) * sg);
                                kk[mi] = (1.f - lb) * (1.f - sg);
                                {
                                    float t;
                                    t = __int_as_float(__builtin_amdgcn_update_dpp(0, __float_as_int(x), 0x111, 0xf, 0xf, false)); if ((fr & segm) >= 1) x += t;
                                    t = __int_as_float(__builtin_amdgcn_update_dpp(0, __float_as_int(x), 0x112, 0xf, 0xf, false)); if ((fr & segm) >= 2) x += t;
                                    t = __int_as_float(__builtin_amdgcn_update_dpp(0, __float_as_int(x), 0x114, 0xf, 0xf, false)); if ((fr & segm) >= 4) x += t;
                                    t = __int_as_float(__builtin_amdgcn_update_dpp(0, __float_as_int(x), 0x118, 0xf, 0xf, false)); if ((fr & segm) >= 8) x += t;
                                }
                                bb[mi] = x;
                            }
                            float bl0, bl1;
#define ROWB(v, n) __int_as_float(__builtin_amdgcn_update_dpp(0, __float_as_int(v), 0x150 + (n), 0xf, 0xf, false))
                            if (isP) { bb[1] += ROWB(bb[0], 15); bl1 = ROWB(bb[1], 15); bl0 = bl1; }
                            else { const float a7 = ROWB(bb[0], 7), a15 = ROWB(bb[0], 15), b7 = ROWB(bb[1], 7), b15 = ROWB(bb[1], 15); bl0 = (fr & 8) ? a15 : a7; bl1 = (fr & 8) ? b15 : b7; }
#undef ROWB
#pragma unroll
                            for (int mi = 0; mi < 2; ++mi) {
                                const float bl = mi ? bl1 : bl0;
                                const float q = silu(acc[ai][0][2 * mm + mi][n][i]);
                                qd[mi][i] = q * __expf(bb[mi]);
                                ki[mi][i] = kk[mi] * __expf(-bb[mi]);
                                ke[mi][i] = kk[mi] * __expf(bl - bb[mi]);
                                dc[mi][i] = __expf(bl);
                            }
                        }
#pragma unroll
                        for (int mi = 0; mi < 2; ++mi) {
                            const int row = rowb + ai * 128 + (2 * mm + mi) * 16;
                            const size_t off = (size_t)row * 512 + cc;
                            u32x2 o;
                            o.x = pk2(qd[mi][0], qd[mi][1]); o.y = pk2(qd[mi][2], qd[mi][3]); *(u32x2*)(QD + off) = o;
                            o.x = pk2(ki[mi][0], ki[mi][1]); o.y = pk2(ki[mi][2], ki[mi][3]); *(u32x2*)(KI + off) = o;
                            o.x = pk2(ke[mi][0], ke[mi][1]); o.y = pk2(ke[mi][2], ke[mi][3]); *(u32x2*)(KE + off) = o;
                            if (isP) {
                                if (mi == 0 && fr == 0) {
                                    const int b = row >> 11, nn = (row & 2047) >> 5, item = (b * 4 + h) * 64 + nn;
                                    *(f32x4*)(DEC + (size_t)item * 128 + cl + 4 * n) = (f32x4){dc[0][0], dc[0][1], dc[0][2], dc[0][3]};
                                }
                            } else if ((fr & 7) == 0) {
                                const int sb = (row - MP) >> 3, item = 2048 + sb * 4 + h;
                                *(f32x4*)(DEC + (size_t)item * 128 + cl + 4 * n) = (f32x4){dc[mi][0], dc[mi][1], dc[mi][2], dc[mi][3]};
                            }
                        }
                    }
        } else {
            const int kind = (pn - 8) >> 1, colb = ((pn - 8) & 1) * 256 + cl;
            if (kind == 0) store_plain<0>(acc, VV, 512, rowb, colb, 1.f);
            else if (kind == 1) store_plain<1>(acc, HGT, 512, rowb, colb, 1.f);
            else store_plain<2>(acc, MQ, 512, rowb, colb, 0.12751743f);
        }
    }
};

template <int ACT> struct EpiPlain {
    bf16_t* O; int ldc;
    __device__ __forceinline__ void operator()(const Acc& acc, const Unit& u, int wr, int wc, int fr, int fq) const {
        store_plain<ACT>(acc, O, ldc, u.pm * 256 + wr * 64 + fr, u.pn * 256 + wc * 32 + 8 * fq, 1.f);
    }
};

struct EpiPlainSplit {
    bf16_t* O; float* P;
    __device__ __forceinline__ void operator()(const Acc& acc, const Unit& u, int wr, int wc, int fr, int fq) const {
        const int row0 = u.pm * 256 + wr * 64 + fr, col0 = u.pn * 256 + wc * 32 + 8 * fq;
        if (u.job == 0) { store_plain<0>(acc, O, 1024, row0, col0, 1.f); return; }
        float* pb = P + (size_t)u.part * 1024 * 1024;
#pragma unroll
        for (int ai = 0; ai < 2; ++ai)
#pragma unroll
            for (int m = 0; m < 4; ++m) {
                float* rowp = pb + (size_t)(row0 + ai * 128 + m * 16 - MP) * 1024 + col0;
#pragma unroll
                for (int bj = 0; bj < 2; ++bj) { *(f32x4*)(rowp + bj * 128) = acc[ai][bj][m][0]; *(f32x4*)(rowp + bj * 128 + 4) = acc[ai][bj][m][1]; }
            }
    }
};

struct EpiMerge {
    bf16_t* MG; const bf16_t* GG;
    __device__ __forceinline__ void merge(Acc& acc, const Unit& u, int wr, int wc, int fr, int fq) const {
        const int rowb = u.pm * 256 + wr * 64 + fr, col0 = u.pn * 256 + wc * 32 + 8 * fq;
        if (u.br < 2) {
#pragma unroll
            for (int ai = 0; ai < 2; ++ai)
#pragma unroll
                for (int m = 0; m < 4; ++m) {
                    const bf16_t* gp = GG + (size_t)(rowb + ai * 128 + m * 16) * NGATE + u.br * 1024 + col0;
#pragma unroll
                    for (int bj = 0; bj < 2; ++bj) {
                        const u32x4 a = *(const u32x4*)(gp + bj * 128), b = *(const u32x4*)(gp + bj * 128 + 1024);
                        f32x4& a0 = acc[ai][bj][m][0]; f32x4& a1 = acc[ai][bj][m][1];
                        a0[0] *= bf_lo(a.x) * __builtin_amdgcn_rcpf(bf_lo(b.x)); a0[1] *= bf_hi(a.x) * __builtin_amdgcn_rcpf(bf_hi(b.x));
                        a0[2] *= bf_lo(a.y) * __builtin_amdgcn_rcpf(bf_lo(b.y)); a0[3] *= bf_hi(a.y) * __builtin_amdgcn_rcpf(bf_hi(b.y));
                        a1[0] *= bf_lo(a.z) * __builtin_amdgcn_rcpf(bf_lo(b.z)); a1[1] *= bf_hi(a.z) * __builtin_amdgcn_rcpf(bf_hi(b.z));
                        a1[2] *= bf_lo(a.w) * __builtin_amdgcn_rcpf(bf_lo(b.w)); a1[3] *= bf_hi(a.w) * __builtin_amdgcn_rcpf(bf_hi(b.w));
                    }
                }
        } else {
#pragma unroll
            for (int ai = 0; ai < 2; ++ai)
#pragma unroll
                for (int m = 0; m < 4; ++m) {
                    const int row = rowb + ai * 128 + m * 16;
#pragma unroll
                    for (int bj = 0; bj < 2; ++bj) {
                        const int col = col0 + bj * 128;
                        const u32x4 g = *(const u32x4*)(GG + (size_t)row * NGATE + 2048 + col);
                        const f32x4 a0 = acc[ai][bj][m][0], a1 = acc[ai][bj][m][1];
                        u32x4 o; o.x = pk2(a0[0] * bf_lo(g.x), a0[1] * bf_hi(g.x)); o.y = pk2(a0[2] * bf_lo(g.y), a0[3] * bf_hi(g.y));
                        o.z = pk2(a1[0] * bf_lo(g.z), a1[1] * bf_hi(g.z)); o.w = pk2(a1[2] * bf_lo(g.w), a1[3] * bf_hi(g.w));
                        *(u32x4*)(MG + (size_t)row * 1024 + col) = o;
                    }
                }
        }
    }
    __device__ __forceinline__ void operator()(const Acc&, const Unit&, int, int, int, int) const {}
};

struct EpiSwiglu {
    bf16_t* F;
    __device__ __forceinline__ void operator()(const Acc& acc, const Unit& u, int wr, int wc, int fr, int fq) const {
        const int rowb = u.pm * 256 + wr * 64 + fr, col0 = u.pn * 128 + wc * 32 + 8 * fq;
#pragma unroll
        for (int ai = 0; ai < 2; ++ai)
#pragma unroll
            for (int m = 0; m < 4; ++m) {
                float v[8];
#pragma unroll
                for (int n = 0; n < 2; ++n)
#pragma unroll
                    for (int i = 0; i < 4; ++i) v[4 * n + i] = silu(acc[ai][0][m][n][i]) * acc[ai][1][m][n][i];
                u32x4 o; o.x = pk2(v[0], v[1]); o.y = pk2(v[2], v[3]); o.z = pk2(v[4], v[5]); o.w = pk2(v[6], v[7]);
                *(u32x4*)(F + (size_t)(rowb + ai * 128 + m * 16) * DFF + col0) = o;
            }
    }
};

struct TrItem { const float* W; bf16_t* WT; int K, N, k0, n0, drow0; };
__device__ __forceinline__ void tr_load(const TrItem& t, float (&v)[32], int lane) {
#pragma unroll
    for (int i = 0; i < 32; ++i) { const int kk = 2 * i + (lane >> 5); v[i] = t.W[(size_t)(t.k0 + kk) * t.N + t.n0 + (lane & 31)]; }
}
__device__ __forceinline__ void tr_finish(const TrItem& t, const float (&v)[32], LAS float* scr, int lane) {
#pragma unroll
    for (int i = 0; i < 32; ++i) { const int kk = 2 * i + (lane >> 5); scr[kk * 33 + (lane & 31)] = v[i]; }
    LDS_WAIT();
    const int c = lane & 7;
#pragma unroll
    for (int j = 0; j < 4; ++j) { const int n = (lane >> 3) + 8 * j; const LAS float* s = scr + (8 * c) * 33 + n;
        u32x4 o; o.x = pk2(s[0 * 33], s[1 * 33]); o.y = pk2(s[2 * 33], s[3 * 33]); o.z = pk2(s[4 * 33], s[5 * 33]); o.w = pk2(s[6 * 33], s[7 * 33]);
        *(u32x4*)(t.WT + (size_t)(t.drow0 + n) * t.K + t.k0 + 8 * c) = o; }
    LDS_WAIT();
}
__device__ __forceinline__ int map_in(int n0) {
    if (n0 >= 2048) return n0;
    const int grp = n0 >> 9, cp = n0 & 511;
    return ((grp >> 1) * 4 + (cp >> 7)) * 256 + (grp & 1) * 128 + (cp & 127);
}
__device__ __forceinline__ void rms_row_bf16(const float* src, const float* gain, bf16_t* dst, int lane) {
    const f32x4* xr = (const f32x4*)src + lane; const f32x4* gr = (const f32x4*)gain + lane;
    f32x4 v[4]; float ss = 0.f;
#pragma unroll
    for (int j = 0; j < 4; ++j) { v[j] = xr[64 * j]; ss += (v[j].x * v[j].x + v[j].y * v[j].y) + (v[j].z * v[j].z + v[j].w * v[j].w); }
    const float r = rsqrtf(wave_sum(ss) * (1.f / 1024.f) + EPS);
    u32x2* o8 = (u32x2*)dst + lane;
#pragma unroll
    for (int j = 0; j < 4; ++j) { const f32x4 g = gr[64 * j]; u32x2 o; o.x = pk2(v[j].x * r * g.x, v[j].y * r * g.y); o.y = pk2(v[j].z * r * g.z, v[j].w * r * g.w); o8[64 * j] = o; }
}
__device__ __forceinline__ void weight_copies(const Params& p, LAS unsigned char* lds, int lo, int hi, int wl, int NW, int lane, int wave) {
    unsigned char* ws = p.ws;
    LAS float* scr = (LAS float*)(lds + wave * 16384);
    bf16_t* WinT = (bf16_t*)(ws + WS_WIN); bf16_t* W3T = (bf16_t*)(ws + WS_W3); bf16_t* WoT = (bf16_t*)(ws + WS_WO);
    bf16_t* WguT = (bf16_t*)(ws + WS_WGU); bf16_t* WdT = (bf16_t*)(ws + WS_WD); bf16_t* WkvT = (bf16_t*)(ws + WS_WKV);
    auto decode = [&](int it, TrItem& t) {
        int r = it; int mode = 0;
        if (r < 3328) { t.W = p.w_in; t.K = 1024; t.N = DIN; t.WT = WinT; mode = 1; }
        else if ((r -= 3328) < 512) { t.W = p.w_mem_kv; t.K = 1024; t.N = 1024; t.WT = WkvT; }
        else if ((r -= 512) < 256) { t.W = p.w_conv_out; t.K = 512; t.N = 1024; t.WT = W3T; }
        else if ((r -= 256) < 256) { t.W = p.w_hg_out; t.K = 512; t.N = 1024; t.WT = W3T + 1024 * 512; }
        else if ((r -= 256) < 256) { t.W = p.w_mem_out; t.K = 512; t.N = 1024; t.WT = W3T + 2 * 1024 * 512; }
        else if ((r -= 256) < 512) { t.W = p.w_out; t.K = 1024; t.N = 1024; t.WT = WoT; }
        else if ((r -= 512) < 1408) { t.W = p.w_gate; t.K = 1024; t.N = DFF; t.WT = WguT; mode = 2; }
        else if ((r -= 1408) < 1408) { t.W = p.w_up; t.K = 1024; t.N = DFF; t.WT = WguT; mode = 3; }
        else { r -= 1408; t.W = p.w_down; t.K = DFF; t.N = 1024; t.WT = WdT; }
        const int nblk = t.N / 32, kb = r / nblk, nb = r - kb * nblk; t.k0 = 64 * kb; t.n0 = 32 * nb;
        t.drow0 = t.n0;
        if (mode == 1) t.drow0 = map_in(t.n0);
        else if (mode >= 2) t.drow0 = 256 * (t.n0 >> 7) + (t.n0 & 127) + (mode == 3 ? 128 : 0);
    };
    for (int it = lo + wl; it < hi; it += 2 * NW) {
        TrItem ta, tb; float va[32], vb[32];
        const bool hb = it + NW < hi;
        decode(it, ta); tr_load(ta, va, lane);
        if (hb) { decode(it + NW, tb); tr_load(tb, vb, lane); }
        tr_finish(ta, va, scr, lane);
        if (hb) tr_finish(tb, vb, scr, lane);
    }
}
__device__ __forceinline__ void phase0(const Params& p, LAS unsigned char* lds, int gw, int NGW, int lane, int wave) {
    unsigned char* ws = p.ws;
    LAS float* scr = (LAS float*)(lds + wave * 16384);
    bf16_t* WinT = (bf16_t*)(ws + WS_WIN); bf16_t* W3T = (bf16_t*)(ws + WS_W3); bf16_t* WoT = (bf16_t*)(ws + WS_WO);
    bf16_t* WguT = (bf16_t*)(ws + WS_WGU); bf16_t* WdT = (bf16_t*)(ws + WS_WD); bf16_t* WkvT = (bf16_t*)(ws + WS_WKV);
    weight_copies(p, lds, 0, 3840, gw, NGW, lane, wave);
    bf16_t* XN = (bf16_t*)(ws + WS_XN); bf16_t* MN = (bf16_t*)(ws + WS_MN);
    for (int row0 = gw; row0 < MT + NMEMROWS; row0 += 4 * NGW) {
        f32x4 v[4][4];
#pragma unroll
        for (int q = 0; q < 4; ++q) {
            const int row = min(row0 + q * NGW, MT + NMEMROWS - 1);
            const float* src = row < MP ? p.x_prompt + (size_t)row * 1024 : (row < MT ? p.x_sample + (size_t)(row - MP) * 1024 : p.mem_prompt + (size_t)(row - MT) * 1024);
#pragma unroll
            for (int j = 0; j < 4; ++j) v[q][j] = ((const f32x4*)src)[lane + 64 * j];
        }
#pragma unroll
        for (int q = 0; q < 4; ++q) {
            const int row = row0 + q * NGW;
            float ss = 0.f;
#pragma unroll
            for (int j = 0; j < 4; ++j) ss += (v[q][j].x * v[q][j].x + v[q][j].y * v[q][j].y) + (v[q][j].z * v[q][j].z + v[q][j].w * v[q][j].w);
            const float r = rsqrtf(wave_sum(ss) * (1.f / 1024.f) + EPS);
            if (row < MT + NMEMROWS) {
                const float* gain = row < MT ? p.g_pre_mix : p.mem_norm_g;
                bf16_t* dst = row < MT ? XN + (size_t)row * 1024 : MN + (size_t)(row - MT) * 1024;
                u32x2* o8 = (u32x2*)dst + lane;
#pragma unroll
                for (int j = 0; j < 4; ++j) { const f32x4 g = ((const f32x4*)gain)[lane + 64 * j]; u32x2 o; o.x = pk2(v[q][j].x * r * g.x, v[q][j].y * r * g.y); o.y = pk2(v[q][j].z * r * g.z, v[q][j].w * r * g.w); o8[64 * j] = o; }
            }
        }
    }
}

template <int T>
__device__ __forceinline__ void conv_item(const Params& p, const bf16_t* U, bf16_t* C, LAS unsigned* cl, bool isP, int rowbase, int t0, int sb, int lane) {
    float s[T], s2[T];
#pragma unroll
    for (int t = 0; t < T; ++t) { s[t] = 0.f; s2[t] = 0.f; }
#pragma unroll 1
    for (int kq = 0; kq < 4; ++kq) {
        const int ch = kq * 128 + 2 * lane;
        float w0[T + 30], w1[T + 30];
#pragma unroll
        for (int r = 0; r < T + 30; ++r) {
            const int tr = t0 - 30 + r;
            if (tr >= 0) { const unsigned uu = *(const unsigned*)(U + (size_t)(rowbase + tr) * 512 + ch); w0[r] = bf_lo(uu); w1[r] = bf_hi(uu); }
            else if (isP) { w0[r] = 0.f; w1[r] = 0.f; }
            else { const f32x2 sv = *(const f32x2*)(p.state_conv + ((size_t)(sb * 30 + 30 + tr)) * 512 + ch); w0[r] = sv.x; w1[r] = sv.y; }
        }
        const f32x2 bias = *(const f32x2*)(p.conv_b + ch);
#pragma unroll
        for (int tg = 0; tg < T; tg += 8) {
            float a0[8], a1[8];
#pragma unroll
            for (int t = 0; t < 8; ++t) { a0[t] = bias.x; a1[t] = bias.y; }
#pragma unroll
            for (int j = 0; j < 31; ++j) {
                const f32x2 w = *(const f32x2*)(p.conv_w + j * 512 + ch);
#pragma unroll
                for (int t = 0; t < 8; ++t) { a0[t] += w.x * w0[tg + t + j]; a1[t] += w.y * w1[tg + t + j]; }
            }
#pragma unroll
            for (int t = 0; t < 8; ++t) { cl[(tg + t) * 256 + kq * 64 + lane] = pk2(a0[t], a1[t]); s[tg + t] += a0[t] + a1[t]; s2[tg + t] += a0[t] * a0[t] + a1[t] * a1[t]; }
            __builtin_amdgcn_sched_barrier(0);
        }
    }
    float mu[T], rstd[T];
#pragma unroll
    for (int t = 0; t < T; ++t) { const float a = wave_sum(s[t]), b = wave_sum(s2[t]); mu[t] = a * (1.f / 512.f); rstd[t] = rsqrtf(fmaxf(b * (1.f / 512.f) - mu[t] * mu[t], 0.f) + EPS); }
#pragma unroll 1
    for (int kq = 0; kq < 4; ++kq) {
        const int ch = kq * 128 + 2 * lane;
        const f32x2 g = *(const f32x2*)(p.ln_g + ch), bb = *(const f32x2*)(p.ln_b + ch);
#pragma unroll
        for (int t = 0; t < T; ++t) {
            const unsigned cv = cl[t * 256 + kq * 64 + lane];
            const float y0 = silu((bf_lo(cv) - mu[t]) * rstd[t] * g.x + bb.x), y1 = silu((bf_hi(cv) - mu[t]) * rstd[t] * g.y + bb.y);
            *(unsigned*)(C + (size_t)(rowbase + t0 + t) * 512 + ch) = pk2(y0, y1);
        }
    }
    LDS_WAIT();
}
template <int C0>
__device__ __forceinline__ void conv_chunk(float (&acc)[64], const float (&w)[31], const LAS unsigned short* win) {
    float x[46];
#pragma unroll
    for (int r = 0; r < 46; ++r) x[r] = bf2f(win[(C0 * 16 + r) * 512]);
#pragma unroll
    for (int i = 0; i < 16; ++i) {
        float a = acc[C0 * 16 + i];
#pragma unroll
        for (int j = 0; j < 31; ++j) a += w[j] * x[i + j];
        acc[C0 * 16 + i] = a;
    }
}
__device__ __forceinline__ void conv_prompt_block(const Params& p, LAS unsigned char* lds, int wave, int lane, int tid) {
    const bf16_t* U = (const bf16_t*)(p.ws + WS_U); bf16_t* C = (bf16_t*)(p.ws + WS_C);
    LAS float* part = (LAS float*)(lds + 96256);
    LAS float* fin = part + 4096;
    const int ch = tid;
    float w[31];
#pragma unroll
    for (int j = 0; j < 31; ++j) w[j] = p.conv_w[j * 512 + ch];
    const float bias = p.conv_b[ch], lg = p.ln_g[ch], lb = p.ln_b[ch];
    for (int it = blockIdx.x; it < 256; it += gridDim.x) {
        const int b = it >> 5, t0 = (it & 31) * 64, rowbase = b * 2048;
        {
            u32x4 cv[12];
#pragma unroll
            for (int i = 0; i < 12; ++i) {
                const int g = tid + 512 * i, row = g >> 6, c = g & 63, tr = t0 - 30 + row;
                cv[i] = (row < 94 && tr >= 0) ? *(const u32x4*)(U + (size_t)(rowbase + tr) * 512 + c * 8) : (u32x4){0u, 0u, 0u, 0u};
            }
#pragma unroll
            for (int i = 0; i < 12; ++i) { const int g = tid + 512 * i, row = g >> 6, c = g & 63; if (row < 94) *(LAS u32x4*)(lds + row * 1024 + c * 16) = cv[i]; }
        }
        __syncthreads();
        float acc[64];
#pragma unroll
        for (int t = 0; t < 64; ++t) acc[t] = bias;
        const LAS unsigned short* win = (const LAS unsigned short*)lds + ch;
        conv_chunk<0>(acc, w, win); conv_chunk<1>(acc, w, win); conv_chunk<2>(acc, w, win); conv_chunk<3>(acc, w, win);
#define ROWSUM(v) do { v += __int_as_float(__builtin_amdgcn_update_dpp(0, __float_as_int(v), 0x111, 0xf, 0xf, false)); v += __int_as_float(__builtin_amdgcn_update_dpp(0, __float_as_int(v), 0x112, 0xf, 0xf, false)); \
                       v += __int_as_float(__builtin_amdgcn_update_dpp(0, __float_as_int(v), 0x114, 0xf, 0xf, false)); v += __int_as_float(__builtin_amdgcn_update_dpp(0, __float_as_int(v), 0x118, 0xf, 0xf, false)); } while (0)
#pragma unroll
        for (int t = 0; t < 64; ++t) {
            float s1 = acc[t], s2 = acc[t] * acc[t];
            ROWSUM(s1); ROWSUM(s2);
            if ((lane & 15) == 15) *(LAS f32x2*)(part + ((wave * 4 + (lane >> 4)) * 64 + t) * 2) = (f32x2){s1, s2};
        }
#undef ROWSUM
        __syncthreads();
        if (tid < 64) {
            float s1 = 0.f, s2 = 0.f;
#pragma unroll
            for (int wv = 0; wv < 32; ++wv) { const f32x2 pv = *(const LAS f32x2*)(part + (wv * 64 + tid) * 2); s1 += pv.x; s2 += pv.y; }
            const float mu = s1 * (1.f / 512.f);
            fin[tid * 2] = mu; fin[tid * 2 + 1] = rsqrtf(fmaxf(s2 * (1.f / 512.f) - mu * mu, 0.f) + EPS);
        }
        __syncthreads();
#pragma unroll
        for (int t = 0; t < 64; ++t) {
            const f32x2 st = *(const LAS f32x2*)(fin + 2 * t);
            const float y = silu((acc[t] - st.x) * st.y * lg + lb);
            C[(size_t)(rowbase + t0 + t) * 512 + ch] = (bf16_t)(pk2(y, 0.f) & 0xffffu);
        }
        __syncthreads();
    }
}
__device__ __forceinline__ void conv_phase(const Params& p, LAS unsigned char* lds, int wave, int gw, int NGW, int lane) {
    const bf16_t* U = (const bf16_t*)(p.ws + WS_U); bf16_t* C = (bf16_t*)(p.ws + WS_C);
    LAS unsigned* cl = (LAS unsigned*)(lds + wave * 16384);
    for (int sb = (gw + NGW - 1024) % NGW; sb < 128; sb += NGW) conv_item<8>(p, U, C, cl, false, MP + sb * 8, 0, sb, lane);
}
__device__ __forceinline__ void convstate_phase(const Params& p, int gtid, int NT) {
    const bf16_t* U = (const bf16_t*)(p.ws + WS_U);
    float* op = p.out + O_CONVP; float* os = p.out + O_CONVS;
    for (int idx = gtid; idx < (8 + 128) * 30 * 64; idx += NT) {
        const int c8 = (idx & 63) * 8, r = idx >> 6;
        f32x4 a, b;
        if (r < 240) { const int i = r % 30, bb = r / 30;
            const u32x4 u = *(const u32x4*)(U + (size_t)(bb * 2048 + 2018 + i) * 512 + c8);
            a = (f32x4){bf_lo(u.x), bf_hi(u.x), bf_lo(u.y), bf_hi(u.y)}; b = (f32x4){bf_lo(u.z), bf_hi(u.z), bf_lo(u.w), bf_hi(u.w)};
            float* o = op + (size_t)r * 512 + c8; *(f32x4*)o = a; *(f32x4*)(o + 4) = b;
        } else { const int rs = r - 240, i = rs % 30, sb = rs / 30;
            if (i < 22) { const float* sp = p.state_conv + ((size_t)(sb * 30 + 8 + i)) * 512 + c8; a = *(const f32x4*)sp; b = *(const f32x4*)(sp + 4); }
            else { const u32x4 u = *(const u32x4*)(U + (size_t)(MP + sb * 8 + i - 22) * 512 + c8);
                a = (f32x4){bf_lo(u.x), bf_hi(u.x), bf_lo(u.y), bf_hi(u.y)}; b = (f32x4){bf_lo(u.z), bf_hi(u.z), bf_lo(u.w), bf_hi(u.w)}; }
            float* o = os + (size_t)rs * 512 + c8; *(f32x4*)o = a; *(f32x4*)(o + 4) = b;
        }
    }
}
template <int NT_>
__device__ __forceinline__ void attn_item(const bf16_t* MQ, const bf16_t* KB, const bf16_t* VT, bf16_t* OM, int kvb, int h, int row0, int nvalid, int l15, int quad) {
    bf16x8 qf[NT_][4];
#pragma unroll
    for (int t = 0; t < NT_; ++t) {
        const int qrow = row0 + t * 16 + (l15 < nvalid ? l15 : nvalid - 1);
#pragma unroll
        for (int kk = 0; kk < 4; ++kk) qf[t][kk] = *(const bf16x8*)(MQ + (size_t)qrow * 512 + h * 128 + kk * 32 + quad * 8);
    }
    const bf16_t* Kb = KB + ((size_t)(kvb * 4 + h) * 256) * 128 + (size_t)l15 * 128 + quad * 8;
    f32x4 s[NT_][16];
#pragma unroll
    for (int kq = 0; kq < 16; kq += 4) {
        bf16x8 kf[4][4];
#pragma unroll
        for (int u = 0; u < 4; ++u)
#pragma unroll
            for (int kk = 0; kk < 4; ++kk) kf[u][kk] = *(const bf16x8*)(Kb + (size_t)((kq + u) * 16) * 128 + kk * 32);
        __builtin_amdgcn_sched_barrier(0);
#pragma unroll
        for (int u = 0; u < 4; ++u) {
#pragma unroll
            for (int t = 0; t < NT_; ++t) s[t][kq + u] = (f32x4){0.f, 0.f, 0.f, 0.f};
#pragma unroll
            for (int kk = 0; kk < 4; ++kk)
#pragma unroll
                for (int t = 0; t < NT_; ++t) s[t][kq + u] = __builtin_amdgcn_mfma_f32_16x16x32_bf16(kf[u][kk], qf[t][kk], s[t][kq + u], 0, 0, 0);
        }
        __builtin_amdgcn_sched_barrier(0);
    }
    float inv[NT_];
    bf16x8 pf[NT_][8];
#pragma unroll
    for (int t = 0; t < NT_; ++t) {
        float mx = -3.0e38f;
#pragma unroll
        for (int kt = 0; kt < 16; ++kt) mx = fmaxf(fmaxf(fmaxf(s[t][kt][0], s[t][kt][1]), fmaxf(s[t][kt][2], s[t][kt][3])), mx);
        mx = fmaxf(mx, __shfl_xor(mx, 16)); mx = fmaxf(mx, __shfl_xor(mx, 32));
        float sum = 0.f;
#pragma unroll
        for (int kt = 0; kt < 16; ++kt)
#pragma unroll
            for (int i = 0; i < 4; ++i) { const float e = __builtin_amdgcn_exp2f(s[t][kt][i] - mx); s[t][kt][i] = e; sum += e; }
        sum += __shfl_xor(sum, 16); sum += __shfl_xor(sum, 32);
        inv[t] = __builtin_amdgcn_rcpf(sum);
#pragma unroll
        for (int kb = 0; kb < 8; ++kb) {
            u32x4 pu; pu.x = pk2(s[t][2 * kb][0], s[t][2 * kb][1]); pu.y = pk2(s[t][2 * kb][2], s[t][2 * kb][3]); pu.z = pk2(s[t][2 * kb + 1][0], s[t][2 * kb + 1][1]); pu.w = pk2(s[t][2 * kb + 1][2], s[t][2 * kb + 1][3]);
            pf[t][kb] = __builtin_bit_cast(bf16x8, pu);
        }
    }
    const bf16_t* Vb = VT + ((size_t)(kvb * 4 + h) * 128) * 256 + (size_t)l15 * 256 + quad * 8;
    f32x4 o[NT_][8];
#pragma unroll
    for (int t = 0; t < NT_; ++t)
#pragma unroll
        for (int vt = 0; vt < 8; ++vt) o[t][vt] = (f32x4){0.f, 0.f, 0.f, 0.f};
#pragma unroll
    for (int kb2 = 0; kb2 < 8; kb2 += 2) {
        bf16x8 vf[2][8];
#pragma unroll
        for (int u = 0; u < 2; ++u)
#pragma unroll
            for (int vt = 0; vt < 8; ++vt) vf[u][vt] = *(const bf16x8*)(Vb + (size_t)(vt * 16) * 256 + (kb2 + u) * 32);
        __builtin_amdgcn_sched_barrier(0);
#pragma unroll
        for (int u = 0; u < 2; ++u)
#pragma unroll
            for (int vt = 0; vt < 8; ++vt)
#pragma unroll
                for (int t = 0; t < NT_; ++t) o[t][vt] = __builtin_amdgcn_mfma_f32_16x16x32_bf16(vf[u][vt], pf[t][kb2 + u], o[t][vt], 0, 0, 0);
        __builtin_amdgcn_sched_barrier(0);
    }
    if (l15 < nvalid) {
#pragma unroll
        for (int t = 0; t < NT_; ++t) {
            bf16_t* op = OM + (size_t)(row0 + t * 16 + l15) * 512 + h * 128 + quad * 4;
#pragma unroll
            for (int vt = 0; vt < 8; ++vt) { u32x2 w; w.x = pk2(o[t][vt][0] * inv[t], o[t][vt][1] * inv[t]); w.y = pk2(o[t][vt][2] * inv[t], o[t][vt][3] * inv[t]); *(u32x2*)(op + vt * 16) = w; }
        }
    }
}
__device__ __forceinline__ void attn_sample_block(const Params& p, LAS unsigned char* lds, int wave, int lane) {
    const bf16_t* MQ = (const bf16_t*)(p.ws + WS_MQ); bf16_t* OM = (bf16_t*)(p.ws + WS_OM);
    const int l15 = lane & 15, quad = lane >> 4;
    LAS float* Pl = (LAS float*)(lds + wave * 16384);
    LAS float* Ow = Pl + 256;
    LAS float* St = Pl + 256 + 1024;
    for (int it = blockIdx.x; it < 512; it += gridDim.x) {
        const int sb = it >> 2, h = it & 3, row0 = MP + sb * 8, key0 = wave * 32;
        bf16x8 qf[4];
#pragma unroll
        for (int kk = 0; kk < 4; ++kk) qf[kk] = *(const bf16x8*)(MQ + (size_t)(row0 + (l15 & 7)) * 512 + h * 128 + kk * 32 + quad * 8);
        const float* Kc = p.cache_k + ((size_t)sb * 256 * 4 + h) * 128 + (size_t)(key0 + l15) * 512 + quad * 8;
        const float* Vc = p.cache_v + ((size_t)sb * 256 * 4 + h) * 128 + (size_t)key0 * 512 + 2 * lane;
        f32x4 ka[2][4], kb[2][4]; f32x2 vv[32];
#pragma unroll
        for (int u = 0; u < 2; ++u)
#pragma unroll
            for (int kk = 0; kk < 4; ++kk) { ka[u][kk] = __builtin_nontemporal_load((const f32x4*)(Kc + (size_t)u * 16 * 512 + kk * 32)); kb[u][kk] = __builtin_nontemporal_load((const f32x4*)(Kc + (size_t)u * 16 * 512 + kk * 32 + 4)); }
#pragma unroll
        for (int k = 0; k < 32; ++k) vv[k] = __builtin_nontemporal_load((const f32x2*)(Vc + (size_t)k * 512));
        f32x4 s[2];
#pragma unroll
        for (int u = 0; u < 2; ++u) {
            s[u] = (f32x4){0.f, 0.f, 0.f, 0.f};
#pragma unroll
            for (int kk = 0; kk < 4; ++kk) {
                u32x4 au; au.x = pk2(ka[u][kk].x, ka[u][kk].y); au.y = pk2(ka[u][kk].z, ka[u][kk].w); au.z = pk2(kb[u][kk].x, kb[u][kk].y); au.w = pk2(kb[u][kk].z, kb[u][kk].w);
                s[u] = __builtin_amdgcn_mfma_f32_16x16x32_bf16(__builtin_bit_cast(bf16x8, au), qf[kk], s[u], 0, 0, 0);
            }
        }
        float mx = fmaxf(fmaxf(fmaxf(s[0][0], s[0][1]), fmaxf(s[0][2], s[0][3])), fmaxf(fmaxf(s[1][0], s[1][1]), fmaxf(s[1][2], s[1][3])));
        mx = fmaxf(mx, __shfl_xor(mx, 16)); mx = fmaxf(mx, __shfl_xor(mx, 32));
        float sum = 0.f;
#pragma unroll
        for (int u = 0; u < 2; ++u)
#pragma unroll
            for (int i = 0; i < 4; ++i) { const float e = __builtin_amdgcn_exp2f(s[u][i] - mx); s[u][i] = e; sum += e; }
        sum += __shfl_xor(sum, 16); sum += __shfl_xor(sum, 32);
        if (l15 < 8) {
#pragma unroll
            for (int u = 0; u < 2; ++u)
#pragma unroll
                for (int i = 0; i < 4; ++i) Pl[(u * 16 + quad * 4 + i) * 8 + l15] = s[u][i];
            if (quad == 0) { St[l15] = mx; St[8 + l15] = sum; }
        }
        LDS_WAIT();
        float o0[8], o1[8];
#pragma unroll
        for (int q = 0; q < 8; ++q) { o0[q] = 0.f; o1[q] = 0.f; }
#pragma unroll
        for (int k = 0; k < 32; ++k) {
            const f32x4 pa = *(const LAS f32x4*)(Pl + k * 8), pb = *(const LAS f32x4*)(Pl + k * 8 + 4);
            o0[0] += pa.x * vv[k].x; o1[0] += pa.x * vv[k].y; o0[1] += pa.y * vv[k].x; o1[1] += pa.y * vv[k].y;
            o0[2] += pa.z * vv[k].x; o1[2] += pa.z * vv[k].y; o0[3] += pa.w * vv[k].x; o1[3] += pa.w * vv[k].y;
            o0[4] += pb.x * vv[k].x; o1[4] += pb.x * vv[k].y; o0[5] += pb.y * vv[k].x; o1[5] += pb.y * vv[k].y;
            o0[6] += pb.z * vv[k].x; o1[6] += pb.z * vv[k].y; o0[7] += pb.w * vv[k].x; o1[7] += pb.w * vv[k].y;
        }
#pragma unroll
        for (int q = 0; q < 8; ++q) *(LAS f32x2*)(Ow + q * 128 + 2 * lane) = (f32x2){o0[q], o1[q]};
        __syncthreads();
        {
            const int q = wave;
            float mw[8], M = -3.0e38f;
#pragma unroll
            for (int w = 0; w < 8; ++w) { mw[w] = ((const LAS float*)(lds + w * 16384))[256 + 1024 + q]; M = fmaxf(M, mw[w]); }
            float den = 0.f, a0 = 0.f, a1 = 0.f;
#pragma unroll
            for (int w = 0; w < 8; ++w) {
                const LAS float* base = (const LAS float*)(lds + w * 16384);
                const float sc = __builtin_amdgcn_exp2f(mw[w] - M);
                den += sc * base[256 + 1024 + 8 + q];
                const f32x2 ov = *(const LAS f32x2*)(base + 256 + q * 128 + 2 * lane);
                a0 += sc * ov.x; a1 += sc * ov.y;
            }
            const float inv = __builtin_amdgcn_rcpf(den);
            *(unsigned*)(OM + (size_t)(row0 + q) * 512 + h * 128 + 2 * lane) = pk2(a0 * inv, a1 * inv);
        }
        __syncthreads();
    }
}
__device__ __forceinline__ void attn_prompt_block(const Params& p, LAS unsigned char* lds, int wave, int lane, int tid) {
    const bf16_t* MQ = (const bf16_t*)(p.ws + WS_MQ); const bf16_t* KB = (const bf16_t*)(p.ws + WS_KB); const bf16_t* VT = (const bf16_t*)(p.ws + WS_VT);
    bf16_t* OM = (bf16_t*)(p.ws + WS_OM);
    const int l15 = lane & 15, quad = lane >> 4;
    for (int grp = blockIdx.x; grp < 256; grp += gridDim.x) {
        const int kvb = grp >> 5, h = (grp >> 3) & 3, row0 = kvb * 2048 + (grp & 7) * 256 + wave * 32;
        {
            const u32x4* kg = (const u32x4*)(KB + ((size_t)(kvb * 4 + h) * 256) * 128);
            const u32x4* vg = (const u32x4*)(VT + ((size_t)(kvb * 4 + h) * 128) * 256);
            u32x4 kc[8], vc[8];
#pragma unroll
            for (int i = 0; i < 8; ++i) { kc[i] = kg[tid + 512 * i]; vc[i] = vg[tid + 512 * i]; }
#pragma unroll
            for (int i = 0; i < 8; ++i) {
                const int g = tid + 512 * i;
                const int kr = g >> 4, kcn = g & 15; *(LAS u32x4*)(lds + kr * 256 + ((kcn ^ (kr & 15)) << 4)) = kc[i];
                const int vr = g >> 5, vcn = g & 31; *(LAS u32x4*)(lds + 65536 + vr * 512 + ((vcn ^ (vr & 15)) << 4)) = vc[i];
            }
        }
        bf16x8 qf[2][4];
#pragma unroll
        for (int t = 0; t < 2; ++t)
#pragma unroll
            for (int kk = 0; kk < 4; ++kk) qf[t][kk] = *(const bf16x8*)(MQ + (size_t)(row0 + t * 16 + l15) * 512 + h * 128 + kk * 32 + quad * 8);
        __syncthreads();
        f32x4 s[2][16];
#pragma unroll
        for (int kt = 0; kt < 16; ++kt) {
            s[0][kt] = (f32x4){0.f, 0.f, 0.f, 0.f}; s[1][kt] = (f32x4){0.f, 0.f, 0.f, 0.f};
#pragma unroll
            for (int kk = 0; kk < 4; ++kk) {
                const bf16x8 a = *(const LAS bf16x8*)(lds + (kt * 16 + l15) * 256 + (((kk * 4 + quad) ^ l15) << 4));
                s[0][kt] = __builtin_amdgcn_mfma_f32_16x16x32_bf16(a, qf[0][kk], s[0][kt], 0, 0, 0);
                s[1][kt] = __builtin_amdgcn_mfma_f32_16x16x32_bf16(a, qf[1][kk], s[1][kt], 0, 0, 0);
            }
        }
        float inv[2]; bf16x8 pf[2][8];
#pragma unroll
        for (int t = 0; t < 2; ++t) {
            float mx = -3.0e38f;
#pragma unroll
            for (int kt = 0; kt < 16; ++kt) mx = fmaxf(fmaxf(fmaxf(s[t][kt][0], s[t][kt][1]), fmaxf(s[t][kt][2], s[t][kt][3])), mx);
            mx = fmaxf(mx, __shfl_xor(mx, 16)); mx = fmaxf(mx, __shfl_xor(mx, 32));
            float sum = 0.f;
#pragma unroll
            for (int kt = 0; kt < 16; ++kt)
#pragma unroll
                for (int i = 0; i < 4; ++i) { const float e = __builtin_amdgcn_exp2f(s[t][kt][i] - mx); s[t][kt][i] = e; sum += e; }
            sum += __shfl_xor(sum, 16); sum += __shfl_xor(sum, 32);
            inv[t] = __builtin_amdgcn_rcpf(sum);
#pragma unroll
            for (int kb = 0; kb < 8; ++kb) {
                u32x4 pu; pu.x = pk2(s[t][2 * kb][0], s[t][2 * kb][1]); pu.y = pk2(s[t][2 * kb][2], s[t][2 * kb][3]); pu.z = pk2(s[t][2 * kb + 1][0], s[t][2 * kb + 1][1]); pu.w = pk2(s[t][2 * kb + 1][2], s[t][2 * kb + 1][3]);
                pf[t][kb] = __builtin_bit_cast(bf16x8, pu);
            }
        }
        f32x4 o[2][8];
#pragma unroll
        for (int t = 0; t < 2; ++t)
#pragma unroll
            for (int vt = 0; vt < 8; ++vt) o[t][vt] = (f32x4){0.f, 0.f, 0.f, 0.f};
#pragma unroll
        for (int kb = 0; kb < 8; ++kb)
#pragma unroll
            for (int vt = 0; vt < 8; ++vt) {
                const bf16x8 a = *(const LAS bf16x8*)(lds + 65536 + (vt * 16 + l15) * 512 + (((kb * 4 + quad) ^ l15) << 4));
                o[0][vt] = __builtin_amdgcn_mfma_f32_16x16x32_bf16(a, pf[0][kb], o[0][vt], 0, 0, 0);
                o[1][vt] = __builtin_amdgcn_mfma_f32_16x16x32_bf16(a, pf[1][kb], o[1][vt], 0, 0, 0);
            }
#pragma unroll
        for (int t = 0; t < 2; ++t) {
            bf16_t* op = OM + (size_t)(row0 + t * 16 + l15) * 512 + h * 128 + quad * 4;
#pragma unroll
            for (int vt = 0; vt < 8; ++vt) { u32x2 w; w.x = pk2(o[t][vt][0] * inv[t], o[t][vt][1] * inv[t]); w.y = pk2(o[t][vt][2] * inv[t], o[t][vt][3] * inv[t]); *(u32x2*)(op + vt * 16) = w; }
        }
        __syncthreads();
    }
}
__device__ __forceinline__ void hg1_phase(const Params& p, int gw, int NGW, int lane) {
    const bf16_t* KE = (const bf16_t*)(p.ws + WS_KE); const bf16_t* VV = (const bf16_t*)(p.ws + WS_VV); const float* DEC = (const float*)(p.ws + WS_DEC);
    bf16_t* KVT = (bf16_t*)(p.out + O_Y);
    const int l15 = lane & 15, quad = lane >> 4;
    for (int itv_ = gw; itv_ < HG1_END * REP_M; itv_ += NGW) { const int item = itv_ % HG1_END;
        const bool isP = item < 2048;
        int rowbase, h, bh;
        if (isP) { bh = item >> 6; h = bh & 3; rowbase = (bh >> 2) * 2048 + (item & 63) * 32; } else { const int s = item - 2048; bh = s; h = s & 3; rowbase = MP + (s >> 2) * 8; }
        const unsigned short lm = (isP || quad == 0) ? (unsigned short)0xffffu : (unsigned short)0u;
        const size_t base = (size_t)(isP ? rowbase + quad * 8 : rowbase) * 512 + h * 128 + l15;
        bf16x8 BF[8];
#pragma unroll
        for (int vt = 0; vt < 8; ++vt)
#pragma unroll
            for (int j = 0; j < 8; ++j) BF[vt][j] = (short)(VV[base + (size_t)j * 512 + vt * 16] & lm);
        bf16x8 AF[8];
#pragma unroll
        for (int dt = 0; dt < 8; ++dt)
#pragma unroll
            for (int j = 0; j < 8; ++j) AF[dt][j] = (short)(KE[base + (size_t)j * 512 + dt * 16] & lm);
        __builtin_amdgcn_sched_barrier(0);
        if (isP) {
#pragma unroll
            for (int dt = 0; dt < 8; ++dt)
#pragma unroll
                for (int vt = 0; vt < 8; ++vt) {
                    const f32x4 a = __builtin_amdgcn_mfma_f32_16x16x32_bf16(AF[dt], BF[vt], (f32x4){0.f, 0.f, 0.f, 0.f}, 0, 0, 0);
                    u32x2 w; w.x = pk2(a[0], a[1]); w.y = pk2(a[2], a[3]);
                    *(u32x2*)(KVT + ((size_t)item * 128 + vt * 16 + l15) * 128 + dt * 16 + quad * 4) = w;
                }
        } else {
#pragma unroll
            for (int dt = 0; dt < 8; ++dt) {
                const int d = dt * 16 + l15;
                const float dec = DEC[(size_t)item * 128 + d];
                const size_t so = ((size_t)bh * 128 + d) * 128 + quad * 4;
                f32x4 s0[8];
#pragma unroll
                for (int vt = 0; vt < 8; ++vt) s0[vt] = *(const f32x4*)(p.state_hgrn + so + vt * 16);
#pragma unroll
                for (int vt = 0; vt < 8; ++vt) {
                    const f32x4 a = __builtin_amdgcn_mfma_f32_16x16x32_bf16(BF[vt], AF[dt], (f32x4){0.f, 0.f, 0.f, 0.f}, 0, 0, 0);
                    *(f32x4*)(p.out + O_HGS + so + vt * 16) = s0[vt] * dec + a;
                }
                __builtin_amdgcn_sched_barrier(0);
            }
        }
    }
}
__device__ __forceinline__ void hg2_phase(const Params& p, int gtid, int NT) {
    bf16_t* KVT = (bf16_t*)(p.out + O_Y); const float* DEC = (const float*)(p.ws + WS_DEC);
    for (int g = gtid; g < 131072; g += NT) {
        const int bh = g >> 12, v = (g >> 5) & 127, d = (g & 31) * 4;
        f32x4 S = (f32x4){0.f, 0.f, 0.f, 0.f};
#pragma unroll 1
        for (int n0 = 0; n0 < 64; n0 += 8) {
            u32x2 kv[8]; f32x4 dec[8];
#pragma unroll
            for (int k = 0; k < 8; ++k) {
                const int item = bh * 64 + n0 + k;
                kv[k] = *(const u32x2*)(KVT + ((size_t)item * 128 + v) * 128 + d); dec[k] = *(const f32x4*)(DEC + (size_t)item * 128 + d);
            }
#pragma unroll
            for (int k = 0; k < 8; ++k) {
                const int item = bh * 64 + n0 + k;
                u32x2 w; w.x = pk2(S[0], S[1]); w.y = pk2(S[2], S[3]); *(u32x2*)(KVT + ((size_t)item * 128 + v) * 128 + d) = w;
                S[0] = dec[k][0] * S[0] + bf_lo(kv[k].x); S[1] = dec[k][1] * S[1] + bf_hi(kv[k].x); S[2] = dec[k][2] * S[2] + bf_lo(kv[k].y); S[3] = dec[k][3] * S[3] + bf_hi(kv[k].y);
            }
        }
        float* o = p.out + O_HGP + ((size_t)bh * 128 + d) * 128 + v;
#pragma unroll
        for (int i = 0; i < 4; ++i) o[(size_t)i * 128] = S[i];
    }
}
__device__ __forceinline__ void hg3_phase(const Params& p, int gw, int NGW, int lane) {
    const bf16_t* QD = (const bf16_t*)(p.ws + WS_QD); const bf16_t* KI = (const bf16_t*)(p.ws + WS_KI); const bf16_t* VV = (const bf16_t*)(p.ws + WS_VV);
    const bf16_t* HGT = (const bf16_t*)(p.ws + WS_HGT); const bf16_t* ST = (const bf16_t*)(p.out + O_Y);
    bf16_t* OG = (bf16_t*)(p.ws + WS_KE);
    const int l15 = lane & 15, quad = lane >> 4;
    for (int itv_ = gw; itv_ < 2560 * REP_M; itv_ += NGW) { const int item = itv_ % 2560;
        const bool isP = item < 2048;
        int rowbase, h, bh;
        if (isP) { bh = item >> 6; h = bh & 3; rowbase = (bh >> 2) * 2048 + (item & 63) * 32; } else { const int s = item - 2048; bh = s; h = s & 3; rowbase = MP + (s >> 2) * 8; }
        const int col0 = h * 128;
        const int r0 = min(rowbase + l15, MT - 1), r1 = min(rowbase + 16 + l15, MT - 1);
        bf16x8 qb[2][4], ka[2][4];
#pragma unroll
        for (int kk = 0; kk < 4; ++kk) {
            qb[0][kk] = *(const bf16x8*)(QD + (size_t)r0 * 512 + col0 + kk * 32 + quad * 8); qb[1][kk] = *(const bf16x8*)(QD + (size_t)r1 * 512 + col0 + kk * 32 + quad * 8);
            ka[0][kk] = *(const bf16x8*)(KI + (size_t)r0 * 512 + col0 + kk * 32 + quad * 8); ka[1][kk] = *(const bf16x8*)(KI + (size_t)r1 * 512 + col0 + kk * 32 + quad * 8);
        }
        f32x4 s00 = (f32x4){0.f, 0.f, 0.f, 0.f}, s01 = s00, s11 = s00;
#pragma unroll
        for (int kk = 0; kk < 4; ++kk) {
            s00 = __builtin_amdgcn_mfma_f32_16x16x32_bf16(ka[0][kk], qb[0][kk], s00, 0, 0, 0);
            s01 = __builtin_amdgcn_mfma_f32_16x16x32_bf16(ka[0][kk], qb[1][kk], s01, 0, 0, 0);
            s11 = __builtin_amdgcn_mfma_f32_16x16x32_bf16(ka[1][kk], qb[1][kk], s11, 0, 0, 0);
        }
#pragma unroll
        for (int r = 0; r < 4; ++r) { const int sl = quad * 4 + r; if (sl > l15) { s00[r] = 0.f; s11[r] = 0.f; } }
        u32x4 pu;
        pu.x = pk2(s00[0], s00[1]); pu.y = pk2(s00[2], s00[3]); pu.z = 0u; pu.w = 0u; const bf16x8 pf0 = __builtin_bit_cast(bf16x8, pu);
        pu.x = pk2(s01[0], s01[1]); pu.y = pk2(s01[2], s01[3]); pu.z = pk2(s11[0], s11[1]); pu.w = pk2(s11[2], s11[3]); const bf16x8 pf1 = __builtin_bit_cast(bf16x8, pu);
        f32x4 o[8][2];
#pragma unroll
        for (int vt = 0; vt < 8; ++vt) {
            bf16x8 vf;
#pragma unroll
            for (int j = 0; j < 8; ++j) { const int sl = j < 4 ? quad * 4 + j : 16 + quad * 4 + (j - 4); vf[j] = (short)VV[(size_t)min(rowbase + sl, MT - 1) * 512 + col0 + vt * 16 + l15]; }
            o[vt][0] = __builtin_amdgcn_mfma_f32_16x16x32_bf16(vf, pf0, (f32x4){0.f, 0.f, 0.f, 0.f}, 0, 0, 0);
            o[vt][1] = __builtin_amdgcn_mfma_f32_16x16x32_bf16(vf, pf1, (f32x4){0.f, 0.f, 0.f, 0.f}, 0, 0, 0);
        }
        {
            const float* S0 = p.state_hgrn + (size_t)bh * 16384;
#pragma unroll 1
            for (int kk = 0; kk < 4; ++kk) {
                const bf16x8 q0 = *(const bf16x8*)(QD + (size_t)r0 * 512 + col0 + kk * 32 + quad * 8);
                if (isP) {
                    const bf16x8 q1 = *(const bf16x8*)(QD + (size_t)r1 * 512 + col0 + kk * 32 + quad * 8);
#pragma unroll
                    for (int vt = 0; vt < 8; ++vt) {
                        const bf16x8 a = *(const bf16x8*)(ST + ((size_t)item * 128 + vt * 16 + l15) * 128 + kk * 32 + quad * 8);
                        o[vt][0] = __builtin_amdgcn_mfma_f32_16x16x32_bf16(a, q0, o[vt][0], 0, 0, 0);
                        o[vt][1] = __builtin_amdgcn_mfma_f32_16x16x32_bf16(a, q1, o[vt][1], 0, 0, 0);
                    }
                } else {
#pragma unroll
                    for (int vt = 0; vt < 8; ++vt) {
                        float sv[8];
#pragma unroll
                        for (int j = 0; j < 8; ++j) sv[j] = S0[(size_t)(kk * 32 + quad * 8 + j) * 128 + vt * 16 + l15];
                        u32x4 au; au.x = pk2(sv[0], sv[1]); au.y = pk2(sv[2], sv[3]); au.z = pk2(sv[4], sv[5]); au.w = pk2(sv[6], sv[7]);
                        o[vt][0] = __builtin_amdgcn_mfma_f32_16x16x32_bf16(__builtin_bit_cast(bf16x8, au), q0, o[vt][0], 0, 0, 0);
                    }
                }
            }
        }
#pragma unroll
        for (int tt = 0; tt < 2; ++tt) {
            float ss = 0.f;
#pragma unroll
            for (int vt = 0; vt < 8; ++vt) ss += (o[vt][tt][0] * o[vt][tt][0] + o[vt][tt][1] * o[vt][tt][1]) + (o[vt][tt][2] * o[vt][tt][2] + o[vt][tt][3] * o[vt][tt][3]);
            ss += __shfl_xor(ss, 16); ss += __shfl_xor(ss, 32);
            const float rn = rsqrtf(ss * (1.f / 128.f) + EPS);
            const bool valid = isP || (tt == 0 && l15 < 8);
            if (valid) {
                const size_t ro = (size_t)(rowbase + tt * 16 + l15) * 512 + col0 + quad * 4;
#pragma unroll
                for (int vt = 0; vt < 8; ++vt) {
                    const f32x4 g = *(const f32x4*)(p.hg_norm_g + vt * 16 + quad * 4);
                    const u32x2 gt = *(const u32x2*)(HGT + ro + vt * 16);
                    u32x2 w; w.x = pk2(o[vt][tt][0] * rn * g[0] * bf_lo(gt.x), o[vt][tt][1] * rn * g[1] * bf_hi(gt.x));
                    w.y = pk2(o[vt][tt][2] * rn * g[2] * bf_lo(gt.y), o[vt][tt][3] * rn * g[3] * bf_hi(gt.y));
                    *(u32x2*)(OG + ro + vt * 16) = w;
                }
            }
        }
    }
}

__device__ __forceinline__ void load_row8(const bf16_t* O, const float* P, int row, int j, int lane, float (&v)[8]) {
    if (row < MP) {
        const u32x4 u = *((const u32x4*)(O + (size_t)row * 1024) + lane + 64 * j);
        v[0] = bf_lo(u.x); v[1] = bf_hi(u.x); v[2] = bf_lo(u.y); v[3] = bf_hi(u.y); v[4] = bf_lo(u.z); v[5] = bf_hi(u.z); v[6] = bf_lo(u.w); v[7] = bf_hi(u.w);
    } else {
        const float* pp = P + (size_t)(row - MP) * 1024 + 512 * j + 8 * lane;
        f32x4 a = *(const f32x4*)pp, b = *(const f32x4*)(pp + 4);
#pragma unroll
        for (int q = 1; q < 4; ++q) { a += *(const f32x4*)(pp + (size_t)q * 1024 * 1024); b += *(const f32x4*)(pp + (size_t)q * 1024 * 1024 + 4); }
        v[0] = a.x; v[1] = a.y; v[2] = a.z; v[3] = a.w; v[4] = b.x; v[5] = b.y; v[6] = b.z; v[7] = b.w;
    }
}
__device__ __forceinline__ void rowpass1(const Params& p, int gw, int NGW, int lane) {
    const bf16_t* MO = (const bf16_t*)(p.ws + WS_VT); bf16_t* H2 = (bf16_t*)(p.ws + WS_XN); const float* PART = (const float*)(p.ws + WS_PART);
    for (int rowa = gw; rowa < MT; rowa += 2 * NGW) {
        float m[2][2][8], x[2][2][8]; float ss[2] = {0.f, 0.f};
#pragma unroll
        for (int q = 0; q < 2; ++q) {
            const int row = min(rowa + q * NGW, MT - 1);
            const float* xr = row < MP ? p.x_prompt + (size_t)row * 1024 : p.x_sample + (size_t)(row - MP) * 1024;
#pragma unroll
            for (int j = 0; j < 2; ++j) {
                load_row8(MO, PART, row, j, lane, m[q][j]);
                const f32x4 a = *(const f32x4*)(xr + 512 * j + 8 * lane), b = *(const f32x4*)(xr + 512 * j + 8 * lane + 4);
                x[q][j][0] = a.x; x[q][j][1] = a.y; x[q][j][2] = a.z; x[q][j][3] = a.w; x[q][j][4] = b.x; x[q][j][5] = b.y; x[q][j][6] = b.z; x[q][j][7] = b.w;
            }
        }
#pragma unroll
        for (int q = 0; q < 2; ++q)
#pragma unroll
            for (int j = 0; j < 2; ++j)
#pragma unroll
                for (int e = 0; e < 8; ++e) ss[q] += m[q][j][e] * m[q][j][e];
        float r1[2], s2[2] = {0.f, 0.f}, r2[2];
#pragma unroll
        for (int q = 0; q < 2; ++q) r1[q] = rsqrtf(wave_sum(ss[q]) * (1.f / 1024.f) + EPS);
#pragma unroll
        for (int j = 0; j < 2; ++j) {
            const f32x4 ga = *(const f32x4*)(p.g_post_mix + 512 * j + 8 * lane), gb = *(const f32x4*)(p.g_post_mix + 512 * j + 8 * lane + 4);
            const float g[8] = {ga.x, ga.y, ga.z, ga.w, gb.x, gb.y, gb.z, gb.w};
#pragma unroll
            for (int q = 0; q < 2; ++q)
#pragma unroll
                for (int e = 0; e < 8; ++e) { x[q][j][e] += m[q][j][e] * r1[q] * g[e]; s2[q] += x[q][j][e] * x[q][j][e]; }
        }
#pragma unroll
        for (int q = 0; q < 2; ++q) r2[q] = rsqrtf(wave_sum(s2[q]) * (1.f / 1024.f) + EPS);
#pragma unroll
        for (int q = 0; q < 2; ++q) {
            const int row = rowa + q * NGW;
            if (row < MT) {
                float* orow = p.out + O_Y + (size_t)row * 1024;
#pragma unroll
                for (int j = 0; j < 2; ++j) {
                    *(f32x4*)(orow + 512 * j + 8 * lane) = (f32x4){x[q][j][0], x[q][j][1], x[q][j][2], x[q][j][3]};
                    *(f32x4*)(orow + 512 * j + 8 * lane + 4) = (f32x4){x[q][j][4], x[q][j][5], x[q][j][6], x[q][j][7]};
                    const f32x4 ga = *(const f32x4*)(p.g_pre_ffn + 512 * j + 8 * lane), gb = *(const f32x4*)(p.g_pre_ffn + 512 * j + 8 * lane + 4);
                    u32x4 o; o.x = pk2(x[q][j][0] * r2[q] * ga.x, x[q][j][1] * r2[q] * ga.y); o.y = pk2(x[q][j][2] * r2[q] * ga.z, x[q][j][3] * r2[q] * ga.w);
                    o.z = pk2(x[q][j][4] * r2[q] * gb.x, x[q][j][5] * r2[q] * gb.y); o.w = pk2(x[q][j][6] * r2[q] * gb.z, x[q][j][7] * r2[q] * gb.w);
                    *((u32x4*)(H2 + (size_t)row * 1024) + lane + 64 * j) = o;
                }
            }
        }
    }
}
__device__ __forceinline__ void rowpass2(const Params& p, int gw, int NGW, int lane) {
    const bf16_t* FO = (const bf16_t*)(p.ws + WS_KB); const float* PART = (const float*)(p.ws + WS_PART);
    for (int rowa = gw; rowa < MT; rowa += 2 * NGW) {
        float f[2][2][8]; f32x4 xa[2][2], xb[2][2]; float ss[2] = {0.f, 0.f};
#pragma unroll
        for (int q = 0; q < 2; ++q) {
            const int row = min(rowa + q * NGW, MT - 1);
            const float* orow = p.out + O_Y + (size_t)row * 1024;
#pragma unroll
            for (int j = 0; j < 2; ++j) {
                load_row8(FO, PART, row, j, lane, f[q][j]);
                xa[q][j] = *(const f32x4*)(orow + 512 * j + 8 * lane); xb[q][j] = *(const f32x4*)(orow + 512 * j + 8 * lane + 4);
            }
        }
#pragma unroll
        for (int q = 0; q < 2; ++q)
#pragma unroll
            for (int j = 0; j < 2; ++j)
#pragma unroll
                for (int e = 0; e < 8; ++e) ss[q] += f[q][j][e] * f[q][j][e];
#pragma unroll
        for (int q = 0; q < 2; ++q) {
            const float r = rsqrtf(wave_sum(ss[q]) * (1.f / 1024.f) + EPS);
            const int row = rowa + q * NGW;
            if (row < MT) {
                float* orow = p.out + O_Y + (size_t)row * 1024;
#pragma unroll
                for (int j = 0; j < 2; ++j) {
                    const f32x4 ga = *(const f32x4*)(p.g_post_ffn + 512 * j + 8 * lane), gb = *(const f32x4*)(p.g_post_ffn + 512 * j + 8 * lane + 4);
                    f32x4 a = xa[q][j], b = xb[q][j];
                    a.x += f[q][j][0] * r * ga.x; a.y += f[q][j][1] * r * ga.y; a.z += f[q][j][2] * r * ga.z; a.w += f[q][j][3] * r * ga.w;
                    b.x += f[q][j][4] * r * gb.x; b.y += f[q][j][5] * r * gb.y; b.z += f[q][j][6] * r * gb.z; b.w += f[q][j][7] * r * gb.w;
                    *(f32x4*)(orow + 512 * j + 8 * lane) = a; *(f32x4*)(orow + 512 * j + 8 * lane + 4) = b;
                }
            }
        }
    }
}

#define XB_TMO      128
#define XB_XCNT(j)  (256  + 64 * (j))
#define XB_XSUB(j)  (1280 + 64 * (j))
#define XB_XGEN(j)  (2304 + 64 * (j))
#define XB_TOP      3328
#define XB_TOPGEN   3392
#define XCD_BAR_WORDS 3456
#define XB_SPIN_CAP (1u << 18)

__device__ __forceinline__ unsigned xb_ld(unsigned* p)              { return __hip_atomic_load(p, __ATOMIC_RELAXED, __HIP_MEMORY_SCOPE_AGENT); }
__device__ __forceinline__ unsigned xb_add(unsigned* p, unsigned v) { return __hip_atomic_fetch_add(p, v, __ATOMIC_RELAXED, __HIP_MEMORY_SCOPE_AGENT); }
__device__ __forceinline__ unsigned xb_xcc_id() { return (unsigned)__builtin_amdgcn_s_getreg((3 << 11) | 20) & 0xFu; }
#define XB_SPIN(cond, bar) do { unsigned _sp = 0; while (cond) { __builtin_amdgcn_s_sleep(1); \
    if ((++_sp & 255u) == 0u) { if (xb_ld(&(bar)[XB_TMO])) break; if (_sp > XB_SPIN_CAP) { atomicAdd(&(bar)[XB_TMO], 1u); break; } } } } while (0)

struct XcdBarrier {
    unsigned* bar; unsigned x;
    volatile LAS unsigned* st;
};

__device__ __forceinline__ XcdBarrier xcd_barrier_post(unsigned* bar, volatile LAS unsigned* st) {
    XcdBarrier b; b.bar = bar; b.x = xb_xcc_id(); b.st = st;
    if (threadIdx.x == 0) (void)xb_add(&bar[XB_XCNT(b.x)], 1u);
    return b;
}
__device__ __forceinline__ void xcd_barrier_complete(unsigned* bar, unsigned x, unsigned& nloc, unsigned& nx) {
    const unsigned G = gridDim.x * gridDim.y * gridDim.z;
    unsigned sum, cnt, mine, sp = 0u;
    for (;;) {
        sum = 0u; cnt = 0u; mine = 0u;
#pragma unroll
        for (unsigned j = 0; j < 16; ++j) { const unsigned c = xb_ld(&bar[XB_XCNT(j)]); sum += c; cnt += (c > 0u) ? 1u : 0u; mine = (j == x) ? c : mine; }
        if (sum == G) break;
        __builtin_amdgcn_s_sleep(1);
        if ((++sp & 255u) == 0u) { if (xb_ld(&bar[XB_TMO])) break; if (sp > XB_SPIN_CAP) { atomicAdd(&bar[XB_TMO], 1u); break; } }
    }
    nloc = mine > 0u ? mine : 1u; nx = cnt > 0u ? cnt : 1u;
}

__device__ __forceinline__ void xcd_barrier(const XcdBarrier& b) {
    asm volatile("s_waitcnt vmcnt(0)" ::: "memory");
    __syncthreads();
    if (threadIdx.x == 0) {
        unsigned* bar = b.bar;
        __builtin_amdgcn_s_waitcnt(0);
        unsigned nloc = b.st[0], nx = b.st[1];
        if (nloc == 0u) { xcd_barrier_complete(bar, b.x, nloc, nx); b.st[0] = nloc; b.st[1] = nx; }
        const unsigned old = xb_add(&bar[XB_XSUB(b.x)], 1u);
        const unsigned gen = old / nloc;
        if (old + 1u == (gen + 1u) * nloc) {
            __builtin_amdgcn_fence(__ATOMIC_RELEASE, "agent");
            asm volatile("s_waitcnt vmcnt(0)" ::: "memory");
            const unsigned og = xb_add(&bar[XB_TOP], 1u);
            const unsigned tg = og / nx;
            if (og + 1u == (tg + 1u) * nx) xb_add(&bar[XB_TOPGEN], 1u);
            else XB_SPIN(xb_ld(&bar[XB_TOPGEN]) == tg, bar);
            __builtin_amdgcn_fence(__ATOMIC_ACQUIRE, "agent");
            xb_add(&bar[XB_XGEN(b.x)], 1u);
            asm volatile("s_waitcnt vmcnt(0)" ::: "memory");
        } else {
            XB_SPIN(xb_ld(&bar[XB_XGEN(b.x)]) == gen, bar);
            __builtin_amdgcn_fence(__ATOMIC_ACQUIRE, "agent");
            asm volatile("s_waitcnt vmcnt(0)" ::: "memory");
        }
    }
    __syncthreads();
}


__global__ void __launch_bounds__(512, 2) mega_fwd(Params p) {
    extern __shared__ __attribute__((aligned(16))) unsigned char lds_raw[];
    LAS unsigned char* lds = (LAS unsigned char*)lds_raw;
    cg::grid_group grid = cg::this_grid();
#define GRID_SYNC() xcd_barrier(xbar)
    const int G = gridDim.x, bx = blockIdx.x, NGW = G * 8, NT = G * 512;
#define IDS() int tid = threadIdx.x; asm volatile("" : "+v"(tid)); const int lane = tid & 63, wave = __builtin_amdgcn_readfirstlane(tid >> 6), gw = bx * 8 + wave, gtid = bx * 512 + tid; (void)lane; (void)gw; (void)gtid
    unsigned char* ws = p.ws;
    if (threadIdx.x < 16) ((volatile LAS unsigned*)(lds + 131072))[threadIdx.x] = 0u;
    __syncthreads();
    const XcdBarrier xbar = xcd_barrier_post((unsigned*)(p.ws + WS_BAR), (volatile LAS unsigned*)(lds + 131072));
    grid.sync();

#ifndef SK_P0
    { IDS(); phase0(p, lds, gw, NGW, lane, wave); }
#endif
    GRID_SYNC();

    {
        pg8::Sched S;
        S.A0 = (const char*)(ws + WS_XN); S.B0 = (const char*)(ws + WS_WIN); S.dAj = (long)WS_MN - (long)WS_XN; S.dBj = (long)WS_WKV - (long)WS_WIN; S.dAb = 0; S.dBb = 0;
        S.nM0 = 68; S.nN0 = 14; S.nt0 = 68 * 14; S.nM1 = 8; S.nN1 = 4; S.nt1 = 32; S.nbr = 1; S.G = G; S.c = bx; S.ktiles = 16; S.split = 0; S.nta = 0; S.ntb = 0; S.tstep = (size_t)256 * 1024 * 2;
        EpiP1 E;
        E.U = (bf16_t*)(ws + WS_U); E.QD = (bf16_t*)(ws + WS_QD); E.KI = (bf16_t*)(ws + WS_KI); E.KE = (bf16_t*)(ws + WS_KE); E.VV = (bf16_t*)(ws + WS_VV); E.HGT = (bf16_t*)(ws + WS_HGT); E.MQ = (bf16_t*)(ws + WS_MQ);
        E.KB = (bf16_t*)(ws + WS_KB); E.VT = (bf16_t*)(ws + WS_VT); E.DEC = (float*)(ws + WS_DEC); E.mk = p.out + O_MK; E.mv = p.out + O_MV; E.lbl = p.lb_logits;
#ifndef SK_P1
        pg8::gemm_phase<EpiP1>(lds, 1024, S, E);
        if (G == 256 && bx >= 216) { IDS(); weight_copies(p, lds, 3840, 5120, (bx - 216) * 8 + wave, 40 * 8, lane, wave); }
        else if (G != 256 && bx == 0) { IDS(); weight_copies(p, lds, 3840, 5120, wave, 8, lane, wave); }
#endif
    }
    GRID_SYNC();

#ifndef SK_ATT
    { IDS(); attn_sample_block(p, lds, wave, lane); }
    { IDS(); attn_prompt_block(p, lds, wave, lane, tid); }
#endif
#ifndef SK_CONV
    { IDS(); conv_prompt_block(p, lds, wave, lane, tid); }
    { IDS(); conv_phase(p, lds, wave, gw, NGW, lane); }
#endif
    { IDS(); convstate_phase(p, gtid, NT); }
#ifndef SK_HG1
    { IDS(); hg1_phase(p, gw, NGW, lane); }
#endif
    GRID_SYNC();
    { IDS(); hg2_phase(p, gtid, NT); }
    GRID_SYNC();
#ifndef SK_HG3
    { IDS(); hg3_phase(p, gw, NGW, lane); }
#endif
    GRID_SYNC();

    {
        pg8::Sched S;
        S.A0 = (const char*)(ws + WS_XN); S.B0 = (const char*)(ws + WS_WIN + (size_t)NPROJ * 1024 * 2); S.dAj = 0; S.dBj = 0; S.dAb = 0; S.dBb = 0;
        S.nM0 = 68; S.nN0 = 12; S.nt0 = 68 * 12; S.nM1 = 1; S.nN1 = 1; S.nt1 = 0; S.nbr = 1; S.G = G; S.c = bx; S.ktiles = 16; S.split = 0; S.nta = 0; S.ntb = 0; S.tstep = (size_t)256 * 1024 * 2;
        EpiPlain<3> E; E.O = (bf16_t*)(ws + WS_U); E.ldc = NGATE;
        pg8::gemm_phase<EpiPlain<3>>(lds, 1024, S, E);
        if (G == 256 && bx >= 48) { IDS(); weight_copies(p, lds, 5120, 9344, (bx - 48) * 8 + wave, 208 * 8, lane, wave); }
        else if (G != 256 && bx == 0) { IDS(); weight_copies(p, lds, 5120, 9344, wave, 8, lane, wave); }
    }
    GRID_SYNC();
    {
        pg8::Sched S;
        S.A0 = (const char*)(ws + WS_C); S.B0 = (const char*)(ws + WS_W3); S.dAj = 0; S.dBj = 0; S.dAb = (long)SZ_ACT512; S.dBb = (long)1024 * 512 * 2;
        S.nM0 = 68; S.nN0 = 4; S.nt0 = 68 * 4; S.nM1 = 1; S.nN1 = 1; S.nt1 = 0; S.nbr = 3; S.G = G; S.c = bx; S.ktiles = 8; S.split = 0; S.nta = 0; S.ntb = 0; S.tstep = (size_t)256 * 512 * 2;
        EpiMerge E; E.MG = (bf16_t*)(ws + WS_KB); E.GG = (const bf16_t*)(ws + WS_U);
        pg8::gemm_phase<EpiMerge, true>(lds, 512, S, E);
    }
    GRID_SYNC();
    {
        pg8::Sched S;
        S.A0 = (const char*)(ws + WS_KB); S.B0 = (const char*)(ws + WS_WO); S.dAj = 0; S.dBj = 0; S.dAb = 0; S.dBb = 0;
        S.nM0 = 64; S.nN0 = 4; S.nt0 = 64 * 4; S.nM1 = 1; S.nN1 = 1; S.nt1 = 0; S.nbr = 1; S.G = G; S.c = bx; S.ktiles = 16; S.split = 1; S.nta = 4; S.ntb = 4; S.tstep = (size_t)256 * 1024 * 2;
        EpiPlainSplit E; E.O = (bf16_t*)(ws + WS_VT); E.P = (float*)(ws + WS_PART);
        pg8::gemm_phase<EpiPlainSplit>(lds, 1024, S, E);
    }
    GRID_SYNC();
    { IDS(); rowpass1(p, gw, NGW, lane); }
    GRID_SYNC();
    {
        pg8::Sched S;
        S.A0 = (const char*)(ws + WS_XN); S.B0 = (const char*)(ws + WS_WGU); S.dAj = 0; S.dBj = 0; S.dAb = 0; S.dBb = 0;
        S.nM0 = 68; S.nN0 = 22; S.nt0 = 68 * 22; S.nM1 = 1; S.nN1 = 1; S.nt1 = 0; S.nbr = 1; S.G = G; S.c = bx; S.ktiles = 16; S.split = 0; S.nta = 0; S.ntb = 0; S.tstep = (size_t)256 * 1024 * 2;
        EpiSwiglu E; E.F = (bf16_t*)(ws + WS_U);
        pg8::gemm_phase<EpiSwiglu>(lds, 1024, S, E);
    }
    GRID_SYNC();
    {
        pg8::Sched S;
        S.A0 = (const char*)(ws + WS_U); S.B0 = (const char*)(ws + WS_WD); S.dAj = 0; S.dBj = 0; S.dAb = 0; S.dBb = 0;
        S.nM0 = 64; S.nN0 = 4; S.nt0 = 64 * 4; S.nM1 = 1; S.nN1 = 1; S.nt1 = 0; S.nbr = 1; S.G = G; S.c = bx; S.ktiles = 44; S.split = 1; S.nta = 12; S.ntb = 10; S.tstep = (size_t)256 * DFF * 2;
        EpiPlainSplit E; E.O = (bf16_t*)(ws + WS_KB); E.P = (float*)(ws + WS_PART);
        pg8::gemm_phase<EpiPlainSplit>(lds, DFF, S, E);
    }
    GRID_SYNC();
    { IDS(); rowpass2(p, gw, NGW, lane); }
}

extern "C" void kernel_launch(void* const* d_in, const int* in_sizes, int n_in, void* d_out, int out_size, void* d_ws, size_t ws_size, hipStream_t stream) {
    static int grid = 0;
    if (grid == 0) {
        if (n_in != 27 || ws_size < WS_END) { fprintf(stderr, "kernel_launch: need 27 inputs and %zu bytes of workspace; got %d, %zu\n", (size_t)WS_END, n_in, ws_size); grid = -1; return; }
        int dev = 0, cus = 0, per_cu = 0;
        hipGetDevice(&dev);
        hipDeviceGetAttribute(&cus, hipDeviceAttributeMultiprocessorCount, dev);
        if (hipFuncSetAttribute((const void*)mega_fwd, hipFuncAttributeMaxDynamicSharedMemorySize, LDS_BYTES) != hipSuccess) { fprintf(stderr, "kernel_launch: hipFuncSetAttribute failed\n"); grid = -1; return; }
        if (hipOccupancyMaxActiveBlocksPerMultiprocessor(&per_cu, (const void*)mega_fwd, 512, LDS_BYTES) != hipSuccess || per_cu < 1) { fprintf(stderr, "kernel_launch: occupancy query failed (%d)\n", per_cu); per_cu = 1; }
        (void)hipGetLastError();
        grid = cus;
        if (grid <= 0) grid = 256;
    }
    if (grid < 0) return;
    if (hipMemsetAsync((char*)d_ws + WS_BAR, 0, 16384, stream) != hipSuccess) { fprintf(stderr, "kernel_launch: memset failed\n"); return; }
    Params p{};
    const float* const* in = (const float* const*)d_in;
    p.x_prompt = in[0]; p.x_sample = in[1]; p.mem_prompt = in[2]; p.state_conv = in[3]; p.state_hgrn = in[4]; p.cache_k = in[5]; p.cache_v = in[6];
    p.g_pre_mix = in[7]; p.g_post_mix = in[8]; p.g_pre_ffn = in[9]; p.g_post_ffn = in[10];
    p.w_in = in[11]; p.conv_w = in[12]; p.conv_b = in[13]; p.ln_g = in[14]; p.ln_b = in[15]; p.w_conv_out = in[16]; p.lb_logits = in[17]; p.hg_norm_g = in[18]; p.w_hg_out = in[19];
    p.mem_norm_g = in[20]; p.w_mem_kv = in[21]; p.w_mem_out = in[22]; p.w_out = in[23]; p.w_gate = in[24]; p.w_up = in[25]; p.w_down = in[26];
    p.out = (float*)d_out; p.ws = (unsigned char*)d_ws;
    void* args[] = {&p};
    hipError_t e = hipLaunchCooperativeKernel((const void*)mega_fwd, dim3(grid), dim3(512), args, LDS_BYTES, stream);
    if (e != hipSuccess) fprintf(stderr, "kernel_launch: cooperative launch failed: %s (grid %d)\n", hipGetErrorString(e), grid);
}
```

```cpp
#include <hip/hip_runtime.h>
#include <hip/hip_cooperative_groups.h>
#include <cstdio>
#include <cstdint>
namespace cg = cooperative_groups;
#ifndef REP_G
#define REP_G 1
#endif
#ifndef REP_M
#define REP_M 1
#endif
#ifndef REP_P0
#define REP_P0 1
#endif
#ifndef REP_C
#define REP_C 1
#endif
#ifndef HG1_END
#define HG1_END 2560
#endif

#define LAS __attribute__((address_space(3)))
typedef unsigned short bf16_t;
typedef short bf16x8 __attribute__((ext_vector_type(8)));
typedef float f32x4 __attribute__((ext_vector_type(4)));
typedef float f32x2 __attribute__((ext_vector_type(2)));
typedef unsigned u32x4 __attribute__((ext_vector_type(4)));
typedef unsigned u32x2 __attribute__((ext_vector_type(2)));

constexpr int DM = 1024, MP = 16384, MS = 1024, MT = MP + MS, DIN = 6656, DFF = 2816, NPROJ = 3584, NGATE = 3072;
constexpr int NMEMROWS = 2048;
constexpr float EPS = 1e-6f;
constexpr int LDS_BYTES = 131072 + 64;

constexpr size_t SZ_ACT512 = (size_t)MT * 512 * 2;
constexpr size_t SZ_ACT1024 = (size_t)MT * 1024 * 2;
constexpr size_t WS_WIN = 0;
constexpr size_t WS_W3 = WS_WIN + (size_t)DIN * 1024 * 2;
constexpr size_t WS_WO = WS_W3 + (size_t)3072 * 512 * 2;
constexpr size_t WS_WGU = WS_WO + (size_t)1024 * 1024 * 2;
constexpr size_t WS_WD = WS_WGU + (size_t)2 * DFF * 1024 * 2;
constexpr size_t WS_WKV = WS_WD + (size_t)1024 * DFF * 2;
constexpr size_t WS_XN = WS_WKV + (size_t)1024 * 1024 * 2;
constexpr size_t WS_KB = WS_XN + SZ_ACT1024;
constexpr size_t WS_VT = WS_KB + SZ_ACT1024;
constexpr size_t WS_U = WS_VT + SZ_ACT1024;
constexpr size_t WS_QD = WS_U + SZ_ACT512;
constexpr size_t WS_KI = WS_QD + SZ_ACT512;
constexpr size_t WS_VV = WS_KI + SZ_ACT512;
constexpr size_t WS_HGT = WS_VV + SZ_ACT512;
constexpr size_t WS_MQ = WS_HGT + SZ_ACT512;
constexpr size_t WS_C = WS_MQ + SZ_ACT512;
constexpr size_t WS_KE = WS_C + SZ_ACT512;
constexpr size_t WS_OM = WS_KE + SZ_ACT512;
constexpr size_t WS_DEC = WS_OM + SZ_ACT512;
constexpr size_t WS_MN = WS_DEC + (size_t)2560 * 128 * 4;
constexpr size_t WS_PART = WS_MN + (size_t)NMEMROWS * 1024 * 2;
constexpr size_t WS_BAR = WS_PART + (size_t)4 * 1024 * 1024 * 4;
constexpr size_t WS_END = WS_BAR + 16384;

constexpr size_t O_Y = 0;
constexpr size_t O_CONVP = (size_t)MT * 1024;
constexpr size_t O_HGP = O_CONVP + 8 * 30 * 512;
constexpr size_t O_MK = O_HGP + 8 * 4 * 128 * 128;
constexpr size_t O_MV = O_MK + 8 * 256 * 512;
constexpr size_t O_CONVS = O_MV + 8 * 256 * 512;
constexpr size_t O_HGS = O_CONVS + 128 * 30 * 512;

struct Params {
    const float *x_prompt, *x_sample, *mem_prompt, *state_conv, *state_hgrn, *cache_k, *cache_v;
    const float *g_pre_mix, *g_post_mix, *g_pre_ffn, *g_post_ffn;
    const float *w_in, *conv_w, *conv_b, *ln_g, *ln_b, *w_conv_out, *lb_logits, *hg_norm_g, *w_hg_out, *mem_norm_g, *w_mem_kv, *w_mem_out, *w_out, *w_gate, *w_up, *w_down;
    float* out;
    unsigned char* ws;
};

typedef __bf16 bf16x2_t __attribute__((ext_vector_type(2)));
__device__ __forceinline__ unsigned pk2(float lo, float hi) { f32x2 v = {lo, hi}; bf16x2_t b = __builtin_convertvector(v, bf16x2_t); return __builtin_bit_cast(unsigned, b); }
__device__ __forceinline__ float bf_lo(unsigned u) { return __uint_as_float(u << 16); }
__device__ __forceinline__ float bf_hi(unsigned u) { return __uint_as_float(u & 0xffff0000u); }
__device__ __forceinline__ float bf2f(bf16_t h) { return __uint_as_float((unsigned)h << 16); }
__device__ __forceinline__ float sigm(float x) { return __builtin_amdgcn_rcpf(1.f + __expf(-x)); }
__device__ __forceinline__ float silu(float x) { return x * sigm(x); }
__device__ __forceinline__ float wave_sum(float v) {
    v += __int_as_float(__builtin_amdgcn_update_dpp(0, __float_as_int(v), 0x111, 0xf, 0xf, false));
    v += __int_as_float(__builtin_amdgcn_update_dpp(0, __float_as_int(v), 0x112, 0xf, 0xf, false));
    v += __int_as_float(__builtin_amdgcn_update_dpp(0, __float_as_int(v), 0x114, 0xf, 0xf, false));
    v += __int_as_float(__builtin_amdgcn_update_dpp(0, __float_as_int(v), 0x118, 0xf, 0xf, false));
    v += __int_as_float(__builtin_amdgcn_update_dpp(0, __float_as_int(v), 0x142, 0xa, 0xf, false));
    v += __int_as_float(__builtin_amdgcn_update_dpp(0, __float_as_int(v), 0x143, 0xc, 0xf, false));
    return __int_as_float(__builtin_amdgcn_readlane(__float_as_int(v), 63));
}
#define LDS_WAIT() asm volatile("s_waitcnt lgkmcnt(0)" ::: "memory")

namespace pg8 {
constexpr int BM = 256, BK = 64, HALF = 128, HTB = HALF * BK * 2, STAGE_BYTES = 8 * HTB, NXCD = 8, WGM = 8;
__device__ __forceinline__ int lds_byte(int r, int c) { const int st = (r >> 4) * 2 + (c >> 5), rr = r & 15, cc = c & 31, ob = rr * 64 + cc * 2; return st * 1024 + (ob ^ (((ob >> 9) & 1) << 5)); }
__device__ __forceinline__ void stage_rc(int b, int& R, int& C) { const int st = b / 1024, sb = b % 1024, swz = sb ^ (((sb >> 9) & 1) << 5); R = (st >> 1) * 16 + swz / 64; C = (st & 1) * 32 + (swz % 64) / 2; }
__device__ __forceinline__ int perm32(int rho) { const int n = rho >> 4, i = rho & 15; return 8 * (i >> 2) + 4 * n + (i & 3); }

struct Unit { int pm, pn, br, job, k0, nt, part; };

__device__ __forceinline__ void tile_map(int L, int nM, int nN, int& pm, int& pn) {
    const int nwg = nM * nN;
    int wgid = L; { const int q = nwg / NXCD, r = nwg % NXCD, xcd = wgid % NXCD, off = wgid / NXCD; wgid = (xcd < r ? xcd * (q + 1) : r * (q + 1) + (xcd - r) * q) + off; }
    const int nig = WGM * nN, gid = wgid / nig, fm = gid * WGM, gsz = (nM - fm) < WGM ? (nM - fm) : WGM;
    pm = fm + ((wgid % nig) % gsz); pn = (wgid % nig) / gsz;
}
struct Sched {
    const char *A0, *B0;
    long dAj, dBj, dAb, dBb;
    int nM0, nN0, nt0, nM1, nN1, nt1, nbr, G, c;
    int ktiles, split, nta, ntb;
    size_t tstep;
    __device__ __forceinline__ bool next(int i, Unit& u) const {
        u.k0 = 0; u.nt = ktiles; u.part = 0;
        if (split) {
            long Ls = (long)i * G + c;
            if (Ls < nt0) { tile_map((int)Ls, nM0, nN0, u.pm, u.pn); u.br = 0; u.job = 0; return true; }
            Ls -= nt0;
            if (Ls < 64) { const int tile = (int)Ls >> 2, part = (int)Ls & 3; u.pm = 64 + (tile >> 2); u.pn = tile & 3; u.br = 0; u.job = 1; u.part = part;
                u.k0 = part < 2 ? part * nta : 2 * nta + (part - 2) * ntb; u.nt = part < 2 ? nta : ntb; return true; }
            return false;
        }
        int ii = i / nbr; const int br = i - ii * nbr;
        if (REP_G > 1) { const int nloc = (nt0 + nt1 - c + G - 1) / G; const int pass = ii / nloc; if (pass >= REP_G) return false; ii -= pass * nloc; }
        long L = (long)ii * G + c;
        if (L < nt0) { tile_map((int)L, nM0, nN0, u.pm, u.pn); u.br = br; u.job = 0; return true; }
        L -= nt0;
        if (L < nt1) { tile_map((int)L, nM1, nN1, u.pm, u.pn); u.br = 0; u.job = 1; return true; }
        return false;
    }
    __device__ __forceinline__ const char* a_base(const Unit& u) const { return A0 + (long)u.job * dAj + (long)u.br * dAb + (size_t)u.pm * tstep + (size_t)u.k0 * (BK * 2); }
    __device__ __forceinline__ const char* b_base(const Unit& u) const { return B0 + (long)u.job * dBj + (long)u.br * dBb + (size_t)u.pn * tstep + (size_t)u.k0 * (BK * 2); }
};

template <class Epi, bool KEEP = false>
__device__ __forceinline__ void gemm_phase(LAS unsigned char* lds, const int K, const Sched& S, const Epi& E) {
    int tid_ = threadIdx.x; asm volatile("" : "+v"(tid_));
    const int tid = tid_, wid = __builtin_amdgcn_readfirstlane(tid >> 6), lane = tid & 63, wr = wid >> 2, wc = wid & 3, fr = lane & 15, fq = lane >> 4;
    unsigned voffA[2], voffB[2];
#pragma unroll
    for (int i = 0; i < 2; ++i) { int R, C; stage_rc(tid * 16 + i * 8192, R, C); const int Rb = (R & ~31) + perm32(R & 31);
        voffA[i] = (unsigned)(R * K + C) * 2u; voffB[i] = (unsigned)(Rb * K + C) * 2u; }
    const size_t kstep = (size_t)(BK * 2);
    const size_t hstep = (size_t)HALF * K * 2;
    const unsigned ldsw = (unsigned)wid * 1024u;
    const int aoff = lds_byte(wr * 64 + fr, fq * 8), boff = lds_byte(wc * 32 + fr, fq * 8);
#define PG8_SA(b, h) (((b) * 2 + (h)) * HTB)
#define PG8_SB(b, h) ((4 + (b) * 2 + (h)) * HTB)
#define PG8_STAGE(bufoff, gbase, voff) do { _Pragma("unroll") for (int _i = 0; _i < 2; ++_i) \
        __builtin_amdgcn_global_load_lds((const unsigned*)((const char*)(gbase) + (voff)[_i]), (LAS unsigned*)(lds + (bufoff) + ldsw + _i * 8192), 16, 0, 0); } while (0)
#define PG8_LDA(dst, b, h) do { _Pragma("unroll") for (int m = 0; m < 4; ++m) _Pragma("unroll") for (int k = 0; k < 2; ++k) dst[m][k] = *(const LAS bf16x8*)(lds + PG8_SA(b, h) + aoff + m * 2048 + k * 1024); } while (0)
#define PG8_LDB(dst, b, h) do { _Pragma("unroll") for (int n = 0; n < 2; ++n) _Pragma("unroll") for (int k = 0; k < 2; ++k) dst[n][k] = *(const LAS bf16x8*)(lds + PG8_SB(b, h) + boff + n * 2048 + k * 1024); } while (0)
#define PG8_MMA(ai, bj, At, Bt) do { __builtin_amdgcn_s_setprio(1); _Pragma("unroll") for (int m = 0; m < 4; ++m) _Pragma("unroll") for (int n = 0; n < 2; ++n) _Pragma("unroll") for (int k = 0; k < 2; ++k) \
        acc[ai][bj][m][n] = __builtin_amdgcn_mfma_f32_16x16x32_bf16(Bt[n][k], At[m][k], acc[ai][bj][m][n], 0, 0, 0); __builtin_amdgcn_s_setprio(0); } while (0)
#define PG8_WAIT_V(n) asm volatile("s_waitcnt vmcnt(" #n ")" ::: "memory")
#define PG8_WAIT_L(n) asm volatile("s_waitcnt lgkmcnt(" #n ")" ::: "memory")
#define PG8_BAR __builtin_amdgcn_s_barrier()
#define PG8_SCHED __builtin_amdgcn_sched_barrier(0)
    Unit cur, nxt; int ui = 0;
    if (!S.next(0, cur)) return;
    f32x4 acc[2][2][4][2];
#pragma unroll
    for (int a = 0; a < 2; ++a)
#pragma unroll
        for (int b = 0; b < 2; ++b)
#pragma unroll
            for (int m = 0; m < 4; ++m)
#pragma unroll
                for (int n = 0; n < 2; ++n) acc[a][b][m][n] = (f32x4){0.f, 0.f, 0.f, 0.f};
    bf16x8 At[4][2], B0[2][2], B1[2][2];
    const char* cA = S.a_base(cur); const char* cB = S.b_base(cur);
    PG8_STAGE(PG8_SB(0, 0), cB, voffB); PG8_STAGE(PG8_SA(0, 0), cA, voffA); PG8_STAGE(PG8_SB(0, 1), cB + hstep, voffB); PG8_STAGE(PG8_SA(0, 1), cA + hstep, voffA);
    if (wr == 1) PG8_BAR;
    PG8_WAIT_V(4); PG8_BAR;
    PG8_STAGE(PG8_SB(1, 0), cB + kstep, voffB); PG8_STAGE(PG8_SA(1, 0), cA + kstep, voffA); PG8_STAGE(PG8_SB(1, 1), cB + hstep + kstep, voffB);
    PG8_WAIT_V(6); PG8_BAR;
    for (;;) {
        const bool has_next = S.next(ui + 1, nxt);
        const char* nA = has_next ? S.a_base(nxt) : cA; const char* nB = has_next ? S.b_base(nxt) : cB;
        const int nt = cur.nt;
        for (int t = 0; t < nt; t += 2) {
            const bool last = (t == nt - 2);
            const char* a1 = cA + (size_t)(t + 1) * kstep;
            const char* a2 = last ? nA : cA + (size_t)(t + 2) * kstep; const char* b2 = last ? nB : cB + (size_t)(t + 2) * kstep;
            const char* a3 = a2 + kstep; const char* b3 = b2 + kstep;
            PG8_LDB(B0, 0, 0); PG8_SCHED; PG8_LDA(At, 0, 0); PG8_STAGE(PG8_SA(1, 1), a1 + hstep, voffA);
            PG8_WAIT_L(8); PG8_BAR; PG8_WAIT_L(0); PG8_MMA(0, 0, At, B0); PG8_BAR; PG8_SCHED;
            PG8_LDB(B1, 0, 1); PG8_STAGE(PG8_SB(0, 0), b2, voffB);
            PG8_BAR; PG8_WAIT_L(0); PG8_MMA(0, 1, At, B1); PG8_BAR;
            PG8_LDA(At, 0, 1); PG8_STAGE(PG8_SA(0, 0), a2, voffA);
            PG8_BAR; PG8_WAIT_L(0); PG8_MMA(1, 0, At, B0); PG8_BAR; PG8_SCHED;
            PG8_STAGE(PG8_SB(0, 1), b2 + hstep, voffB);
            PG8_WAIT_V(6); PG8_BAR; PG8_MMA(1, 1, At, B1); PG8_BAR;
            PG8_LDB(B0, 1, 0); PG8_SCHED; PG8_LDA(At, 1, 0); PG8_STAGE(PG8_SA(0, 1), a2 + hstep, voffA);
            PG8_WAIT_L(8); PG8_BAR; PG8_WAIT_L(0); PG8_MMA(0, 0, At, B0); PG8_BAR; PG8_SCHED;
            PG8_LDB(B1, 1, 1); PG8_STAGE(PG8_SB(1, 0), b3, voffB);
            PG8_BAR; PG8_WAIT_L(0); PG8_MMA(0, 1, At, B1); PG8_BAR;
            PG8_LDA(At, 1, 1); PG8_STAGE(PG8_SA(1, 0), a3, voffA);
            PG8_BAR; PG8_WAIT_L(0); PG8_MMA(1, 0, At, B0); PG8_BAR; PG8_SCHED;
            PG8_STAGE(PG8_SB(1, 1), b3 + hstep, voffB);
            PG8_WAIT_V(6); PG8_BAR; PG8_MMA(1, 1, At, B1); PG8_BAR;
        }
        bool clear = true;
        if constexpr (KEEP) { E.merge(acc, cur, wr, wc, fr, fq); clear = (cur.br == 2); } else E(acc, cur, wr, wc, fr, fq);
        if (!has_next) break;
        if (clear)
#pragma unroll
        for (int a = 0; a < 2; ++a)
#pragma unroll
            for (int b = 0; b < 2; ++b)
#pragma unroll
                for (int m = 0; m < 4; ++m)
#pragma unroll
                    for (int n = 0; n < 2; ++n) acc[a][b][m][n] = (f32x4){0.f, 0.f, 0.f, 0.f};
        cur = nxt; cA = nA; cB = nB; ++ui;
    }
    PG8_WAIT_V(0);
    if (wr == 0) PG8_BAR;
    PG8_BAR;
#undef PG8_SA
#undef PG8_SB
#undef PG8_STAGE
#undef PG8_LDA
#undef PG8_LDB
#undef PG8_MMA
#undef PG8_WAIT_V
#undef PG8_WAIT_L
#undef PG8_BAR
#undef PG8_SCHED
}
}
using pg8::Unit;
typedef f32x4 Acc[2][2][4][2];

template <int ACT>
__device__ __forceinline__ void store_plain(const Acc& acc, bf16_t* O, int ldc, int row0, int col0, float scale) {
#pragma unroll
    for (int ai = 0; ai < 2; ++ai)
#pragma unroll
        for (int m = 0; m < 4; ++m) {
            bf16_t* rowp = O + (size_t)(row0 + ai * 128 + m * 16) * ldc + col0;
#pragma unroll
            for (int bj = 0; bj < 2; ++bj) {
                float v[8];
#pragma unroll
                for (int n = 0; n < 2; ++n)
#pragma unroll
                    for (int i = 0; i < 4; ++i) { float x = acc[ai][bj][m][n][i]; if (ACT == 1) x = silu(x); else if (ACT == 2) x *= scale; else if (ACT == 3) x = fmaxf(sigm(x), 1e-30f); v[4 * n + i] = x; }
                u32x4 o; o.x = pk2(v[0], v[1]); o.y = pk2(v[2], v[3]); o.z = pk2(v[4], v[5]); o.w = pk2(v[6], v[7]);
                *(u32x4*)(rowp + bj * 128) = o;
            }
        }
}

struct EpiP1 {
    bf16_t *U, *QD, *KI, *KE, *VV, *HGT, *MQ, *KB, *VT;
    float *DEC, *mk, *mv;
    const float* lbl;
    __device__ __forceinline__ void operator()(const Acc& acc, const Unit& u, int wr, int wc, int fr, int fq) const {
        const int rowb = u.pm * 256 + wr * 64 + fr, cl = wc * 32 + 8 * fq;
        if (u.job == 1) {
            const int b = u.pm;
#pragma unroll
            for (int ai = 0; ai < 2; ++ai)
#pragma unroll
                for (int m = 0; m < 4; ++m) {
                    const int key = ai * 128 + wr * 64 + m * 16 + fr, row = b * 256 + key;
#pragma unroll
                    for (int bj = 0; bj < 2; ++bj) {
                        const f32x4 v0 = acc[ai][bj][m][0], v1 = acc[ai][bj][m][1];
                        if (u.pn < 2) {
                            const int h = 2 * u.pn + bj, c = h * 128 + cl;
                            float* o = mk + (size_t)row * 512 + c; *(f32x4*)o = v0; *(f32x4*)(o + 4) = v1;
                            u32x4 pk; pk.x = pk2(v0[0], v0[1]); pk.y = pk2(v0[2], v0[3]); pk.z = pk2(v1[0], v1[1]); pk.w = pk2(v1[2], v1[3]);
                            *(u32x4*)(KB + ((size_t)((b * 4 + h) * 256 + key)) * 128 + cl) = pk;
                        } else {
                            const int h = 2 * (u.pn - 2) + bj, c = h * 128 + cl;
                            float* o = mv + (size_t)row * 512 + c; *(f32x4*)o = v0; *(f32x4*)(o + 4) = v1;
                            const int ko = key & 31, kp = (key & ~31) + ((ko & 15) >> 2) * 8 + (ko & 3) + ((ko >> 4) << 2);
                            bf16_t* vt = VT + ((size_t)((b * 4 + h) * 128 + cl)) * 256 + kp;
#pragma unroll
                            for (int i = 0; i < 4; ++i) { vt[(size_t)i * 256] = (bf16_t)(pk2(v0[i], 0.f) & 0xffffu); vt[(size_t)(4 + i) * 256] = (bf16_t)(pk2(v1[i], 0.f) & 0xffffu); }
                        }
                    }
                }
            return;
        }
        const int pn = u.pn;
        if (pn < 4) {
#pragma unroll
            for (int ai = 0; ai < 2; ++ai)
#pragma unroll
                for (int m = 0; m < 4; ++m) {
                    float v[8];
#pragma unroll
                    for (int n = 0; n < 2; ++n)
#pragma unroll
                        for (int i = 0; i < 4; ++i) v[4 * n + i] = acc[ai][0][m][n][i] * sigm(acc[ai][1][m][n][i]);
                    u32x4 o; o.x = pk2(v[0], v[1]); o.y = pk2(v[2], v[3]); o.z = pk2(v[4], v[5]); o.w = pk2(v[6], v[7]);
                    *(u32x4*)(U + (size_t)(rowb + ai * 128 + m * 16) * 512 + pn * 128 + cl) = o;
                }
        } else if (pn < 8) {
            const int h = pn - 4;
            const bool isP = u.pm < 64;
            const int segm = isP ? 15 : 7;
#pragma unroll
            for (int ai = 0; ai < 2; ++ai)
#pragma unroll
                for (int mm = 0; mm < 2; ++mm) {
                    u32x2 hq[2], hi[2], he[2];
#pragma unroll
                    for (int n = 0; n < 2; ++n) {
                        const int cc = h * 128 + cl + 4 * n;
                        const f32x4 l0 = *(const f32x4*)(lbl + cc), l1 = *(const f32x4*)(lbl + 512 + cc);
                        float qd[2][4], ki[2][4], ke[2][4], dc[2][4];
#pragma unroll
                        for (int i = 0; i < 4; ++i) {
                            const float lb = sigm(l0[i] - l1[i]);
                            float bb[2], kk[2];
#pragma unroll
                            for (int mi = 0; mi < 2; ++mi) {
                                const float fx = acc[ai][1][2 * mm + mi][n][i];
                                const float sg = sigm(fx);
                                float x = __logf(lb + (1.f - lb) * sg);
                                kk[mi] = (1.f - lb) * (1.f - sg);
                                {
                                    float t;
                                    t = __int_as_float(__builtin_amdgcn_update_dpp(0, __float_as_int(x), 0x111, 0xf, 0xf, false)); if ((fr & segm) >= 1) x += t;
                                    t = __int_as_float(__builtin_amdgcn_update_dpp(0, __float_as_int(x), 0x112, 0xf, 0xf, false)); if ((fr & segm) >= 2) x += t;
                                    t = __int_as_float(__builtin_amdgcn_update_dpp(0, __float_as_int(x), 0x114, 0xf, 0xf, false)); if ((fr & segm) >= 4) x += t;
                                    t = __int_as_float(__builtin_amdgcn_update_dpp(0, __float_as_int(x), 0x118, 0xf, 0xf, false)); if ((fr & segm) >= 8) x += t;
                                }
                                bb[mi] = x;
                            }
                            float bl0, bl1;
#define ROWB(v, n) __int_as_float(__builtin_amdgcn_update_dpp(0, __float_as_int(v), 0x150 + (n), 0xf, 0xf, false))
                            if (isP) { bb[1] += ROWB(bb[0], 15); bl1 = ROWB(bb[1], 15); bl0 = bl1; }
                            else { const float a7 = ROWB(bb[0], 7), a15 = ROWB(bb[0], 15), b7 = ROWB(bb[1], 7), b15 = ROWB(bb[1], 15); bl0 = (fr & 8) ? a15 : a7; bl1 = (fr & 8) ? b15 : b7; }
#undef ROWB
#pragma unroll
                            for (int mi = 0; mi < 2; ++mi) {
                                const float bl = mi ? bl1 : bl0;
                                const float q = silu(acc[ai][0][2 * mm + mi][n][i]);
                                qd[mi][i] = q * __expf(bb[mi]);
                                ki[mi][i] = kk[mi] * __expf(-bb[mi]);
                                ke[mi][i] = kk[mi] * __expf(bl - bb[mi]);
                                dc[mi][i] = __expf(bl);
                            }
                        }
#pragma unroll
                        for (int mi = 0; mi < 2; ++mi) {
                            const int row = rowb + ai * 128 + (2 * mm + mi) * 16;
                            const size_t off = (size_t)row * 512 + h * 128 + cl;
                            u32x2 oq, oi, oe;
                            oq.x = pk2(qd[mi][0], qd[mi][1]); oq.y = pk2(qd[mi][2], qd[mi][3]);
                            oi.x = pk2(ki[mi][0], ki[mi][1]); oi.y = pk2(ki[mi][2], ki[mi][3]);
                            oe.x = pk2(ke[mi][0], ke[mi][1]); oe.y = pk2(ke[mi][2], ke[mi][3]);
                            if (n == 0) { hq[mi] = oq; hi[mi] = oi; he[mi] = oe; }
                            else {
                                *(u32x4*)(QD + off) = (u32x4){hq[mi].x, hq[mi].y, oq.x, oq.y};
                                *(u32x4*)(KI + off) = (u32x4){hi[mi].x, hi[mi].y, oi.x, oi.y};
                                *(u32x4*)(KE + off) = (u32x4){he[mi].x, he[mi].y, oe.x, oe.y};
                            }
                            if (isP) {
                                if (mi == 0 && fr == 0) {
                                    const int b = row >> 11, nn = (row & 2047) >> 5, item = (b * 4 + h) * 64 + nn;
                                    *(f32x4*)(DEC + (size_t)item * 128 + cl + 4 * n) = (f32x4){dc[0][0], dc[0][1], dc[0][2], dc[0][3]};
                                }
                            } else if ((fr & 7) == 0) {
                                const int sb = (row - MP) >> 3, item = 2048 + sb * 4 + h;
                                *(f32x4*)(DEC + (size_t)item * 128 + cl + 4 * n) = (f32x4){dc[mi][0], dc[mi][1], dc[mi][2], dc[mi][3]};
                            }
                        }
                    }
                }
        } else {
            const int kind = (pn - 8) >> 1, colb = ((pn - 8) & 1) * 256 + cl;
            if (kind == 0) store_plain<0>(acc, VV, 512, rowb, colb, 1.f);
            else if (kind == 1) store_plain<1>(acc, HGT, 512, rowb, colb, 1.f);
            else store_plain<2>(acc, MQ, 512, rowb, colb, 0.12751743f);
        }
    }
};

template <int ACT> struct EpiPlain {
    bf16_t* O; int ldc;
    __device__ __forceinline__ void operator()(const Acc& acc, const Unit& u, int wr, int wc, int fr, int fq) const {
        store_plain<ACT>(acc, O, ldc, u.pm * 256 + wr * 64 + fr, u.pn * 256 + wc * 32 + 8 * fq, 1.f);
    }
};

struct EpiPlainSplit {
    bf16_t* O; float* P;
    __device__ __forceinline__ void operator()(const Acc& acc, const Unit& u, int wr, int wc, int fr, int fq) const {
        const int row0 = u.pm * 256 + wr * 64 + fr, col0 = u.pn * 256 + wc * 32 + 8 * fq;
        if (u.job == 0) { store_plain<0>(acc, O, 1024, row0, col0, 1.f); return; }
        float* pb = P + (size_t)u.part * 1024 * 1024;
#pragma unroll
        for (int ai = 0; ai < 2; ++ai)
#pragma unroll
            for (int m = 0; m < 4; ++m) {
                float* rowp = pb + (size_t)(row0 + ai * 128 + m * 16 - MP) * 1024 + col0;
#pragma unroll
                for (int bj = 0; bj < 2; ++bj) { *(f32x4*)(rowp + bj * 128) = acc[ai][bj][m][0]; *(f32x4*)(rowp + bj * 128 + 4) = acc[ai][bj][m][1]; }
            }
    }
};

struct EpiMerge {
    bf16_t* MG; const bf16_t* GG;
    __device__ __forceinline__ void merge(Acc& acc, const Unit& u, int wr, int wc, int fr, int fq) const {
        const int rowb = u.pm * 256 + wr * 64 + fr, col0 = u.pn * 256 + wc * 32 + 8 * fq;
        if (u.br < 2) {
#pragma unroll
            for (int ai = 0; ai < 2; ++ai)
#pragma unroll
                for (int m = 0; m < 4; ++m) {
                    const bf16_t* gp = GG + (size_t)(rowb + ai * 128 + m * 16) * NGATE + u.br * 1024 + col0;
#pragma unroll
                    for (int bj = 0; bj < 2; ++bj) {
                        const u32x4 a = *(const u32x4*)(gp + bj * 128), b = *(const u32x4*)(gp + bj * 128 + 1024);
                        f32x4& a0 = acc[ai][bj][m][0]; f32x4& a1 = acc[ai][bj][m][1];
                        a0[0] *= bf_lo(a.x) * __builtin_amdgcn_rcpf(bf_lo(b.x)); a0[1] *= bf_hi(a.x) * __builtin_amdgcn_rcpf(bf_hi(b.x));
                        a0[2] *= bf_lo(a.y) * __builtin_amdgcn_rcpf(bf_lo(b.y)); a0[3] *= bf_hi(a.y) * __builtin_amdgcn_rcpf(bf_hi(b.y));
                        a1[0] *= bf_lo(a.z) * __builtin_amdgcn_rcpf(bf_lo(b.z)); a1[1] *= bf_hi(a.z) * __builtin_amdgcn_rcpf(bf_hi(b.z));
                        a1[2] *= bf_lo(a.w) * __builtin_amdgcn_rcpf(bf_lo(b.w)); a1[3] *= bf_hi(a.w) * __builtin_amdgcn_rcpf(bf_hi(b.w));
                    }
                }
        } else {
#pragma unroll
            for (int ai = 0; ai < 2; ++ai)
#pragma unroll
                for (int m = 0; m < 4; ++m) {
                    const int row = rowb + ai * 128 + m * 16;
#pragma unroll
                    for (int bj = 0; bj < 2; ++bj) {
                        const int col = col0 + bj * 128;
                        const u32x4 g = *(const u32x4*)(GG + (size_t)row * NGATE + 2048 + col);
                        const f32x4 a0 = acc[ai][bj][m][0], a1 = acc[ai][bj][m][1];
                        u32x4 o; o.x = pk2(a0[0] * bf_lo(g.x), a0[1] * bf_hi(g.x)); o.y = pk2(a0[2] * bf_lo(g.y), a0[3] * bf_hi(g.y));
                        o.z = pk2(a1[0] * bf_lo(g.z), a1[1] * bf_hi(g.z)); o.w = pk2(a1[2] * bf_lo(g.w), a1[3] * bf_hi(g.w));
                        *(u32x4*)(MG + (size_t)row * 1024 + col) = o;
                    }
                }
        }
    }
    __device__ __forceinline__ void operator()(const Acc&, const Unit&, int, int, int, int) const {}
};

struct EpiSwiglu {
    bf16_t* F;
    __device__ __forceinline__ void operator()(const Acc& acc, const Unit& u, int wr, int wc, int fr, int fq) const {
        const int rowb = u.pm * 256 + wr * 64 + fr, col0 = u.pn * 128 + wc * 32 + 8 * fq;
#pragma unroll
        for (int ai = 0; ai < 2; ++ai)
#pragma unroll
            for (int m = 0; m < 4; ++m) {
                float v[8];
#pragma unroll
                for (int n = 0; n < 2; ++n)
#pragma unroll
                    for (int i = 0; i < 4; ++i) v[4 * n + i] = silu(acc[ai][0][m][n][i]) * acc[ai][1][m][n][i];
                u32x4 o; o.x = pk2(v[0], v[1]); o.y = pk2(v[2], v[3]); o.z = pk2(v[4], v[5]); o.w = pk2(v[6], v[7]);
                *(u32x4*)(F + (size_t)(rowb + ai * 128 + m * 16) * DFF + col0) = o;
            }
    }
};

struct TrItem { const float* W; bf16_t* WT; int K, N, k0, n0, drow0; };
__device__ __forceinline__ void tr_load(const TrItem& t, float (&v)[32], int lane) {
#pragma unroll
    for (int i = 0; i < 32; ++i) { const int kk = 2 * i + (lane >> 5); v[i] = t.W[(size_t)(t.k0 + kk) * t.N + t.n0 + (lane & 31)]; }
}
__device__ __forceinline__ void tr_finish(const TrItem& t, const float (&v)[32], LAS float* scr, int lane) {
#pragma unroll
    for (int i = 0; i < 32; ++i) { const int kk = 2 * i + (lane >> 5); scr[kk * 33 + (lane & 31)] = v[i]; }
    LDS_WAIT();
    const int c = lane & 7;
#pragma unroll
    for (int j = 0; j < 4; ++j) { const int n = (lane >> 3) + 8 * j; const LAS float* s = scr + (8 * c) * 33 + n;
        u32x4 o; o.x = pk2(s[0 * 33], s[1 * 33]); o.y = pk2(s[2 * 33], s[3 * 33]); o.z = pk2(s[4 * 33], s[5 * 33]); o.w = pk2(s[6 * 33], s[7 * 33]);
        *(u32x4*)(t.WT + (size_t)(t.drow0 + n) * t.K + t.k0 + 8 * c) = o; }
    LDS_WAIT();
}
__device__ __forceinline__ int map_in(int n0) {
    if (n0 >= 2048) return n0;
    const int grp = n0 >> 9, cp = n0 & 511;
    return ((grp >> 1) * 4 + (cp >> 7)) * 256 + (grp & 1) * 128 + (cp & 127);
}
__device__ __forceinline__ void rms_row_bf16(const float* src, const float* gain, bf16_t* dst, int lane) {
    const f32x4* xr = (const f32x4*)src + lane; const f32x4* gr = (const f32x4*)gain + lane;
    f32x4 v[4]; float ss = 0.f;
#pragma unroll
    for (int j = 0; j < 4; ++j) { v[j] = xr[64 * j]; ss += (v[j].x * v[j].x + v[j].y * v[j].y) + (v[j].z * v[j].z + v[j].w * v[j].w); }
    const float r = rsqrtf(wave_sum(ss) * (1.f / 1024.f) + EPS);
    u32x2* o8 = (u32x2*)dst + lane;
#pragma unroll
    for (int j = 0; j < 4; ++j) { const f32x4 g = gr[64 * j]; u32x2 o; o.x = pk2(v[j].x * r * g.x, v[j].y * r * g.y); o.y = pk2(v[j].z * r * g.z, v[j].w * r * g.w); o8[64 * j] = o; }
}
__device__ __forceinline__ void weight_copies(const Params& p, LAS unsigned char* lds, int lo, int hi, int wl, int NW, int lane, int wave) {
    unsigned char* ws = p.ws;
    LAS float* scr = (LAS float*)(lds + wave * 16384);
    bf16_t* WinT = (bf16_t*)(ws + WS_WIN); bf16_t* W3T = (bf16_t*)(ws + WS_W3); bf16_t* WoT = (bf16_t*)(ws + WS_WO);
    bf16_t* WguT = (bf16_t*)(ws + WS_WGU); bf16_t* WdT = (bf16_t*)(ws + WS_WD); bf16_t* WkvT = (bf16_t*)(ws + WS_WKV);
    auto decode = [&](int it, TrItem& t) {
        int r = it; int mode = 0;
        if (r < 3328) { t.W = p.w_in; t.K = 1024; t.N = DIN; t.WT = WinT; mode = 1; }
        else if ((r -= 3328) < 512) { t.W = p.w_mem_kv; t.K = 1024; t.N = 1024; t.WT = WkvT; }
        else if ((r -= 512) < 256) { t.W = p.w_conv_out; t.K = 512; t.N = 1024; t.WT = W3T; }
        else if ((r -= 256) < 256) { t.W = p.w_hg_out; t.K = 512; t.N = 1024; t.WT = W3T + 1024 * 512; }
        else if ((r -= 256) < 256) { t.W = p.w_mem_out; t.K = 512; t.N = 1024; t.WT = W3T + 2 * 1024 * 512; }
        else if ((r -= 256) < 512) { t.W = p.w_out; t.K = 1024; t.N = 1024; t.WT = WoT; }
        else if ((r -= 512) < 1408) { t.W = p.w_gate; t.K = 1024; t.N = DFF; t.WT = WguT; mode = 2; }
        else if ((r -= 1408) < 1408) { t.W = p.w_up; t.K = 1024; t.N = DFF; t.WT = WguT; mode = 3; }
        else { r -= 1408; t.W = p.w_down; t.K = DFF; t.N = 1024; t.WT = WdT; }
        const int nblk = t.N / 32, kb = r / nblk, nb = r - kb * nblk; t.k0 = 64 * kb; t.n0 = 32 * nb;
        t.drow0 = t.n0;
        if (mode == 1) t.drow0 = map_in(t.n0);
        else if (mode >= 2) t.drow0 = 256 * (t.n0 >> 7) + (t.n0 & 127) + (mode == 3 ? 128 : 0);
    };
    for (int it = lo + wl; it < hi; it += 2 * NW) {
        TrItem ta, tb; float va[32], vb[32];
        const bool hb = it + NW < hi;
        decode(it, ta); tr_load(ta, va, lane);
        if (hb) { decode(it + NW, tb); tr_load(tb, vb, lane); }
        tr_finish(ta, va, scr, lane);
        if (hb) tr_finish(tb, vb, scr, lane);
    }
}
__device__ __forceinline__ void phase0(const Params& p, LAS unsigned char* lds, int gw, int NGW, int lane, int wave) {
    unsigned char* ws = p.ws;
    LAS float* scr = (LAS float*)(lds + wave * 16384);
    bf16_t* WinT = (bf16_t*)(ws + WS_WIN); bf16_t* W3T = (bf16_t*)(ws + WS_W3); bf16_t* WoT = (bf16_t*)(ws + WS_WO);
    bf16_t* WguT = (bf16_t*)(ws + WS_WGU); bf16_t* WdT = (bf16_t*)(ws + WS_WD); bf16_t* WkvT = (bf16_t*)(ws + WS_WKV);
    weight_copies(p, lds, 0, 3840, gw, NGW, lane, wave);
    bf16_t* XN = (bf16_t*)(ws + WS_XN); bf16_t* MN = (bf16_t*)(ws + WS_MN);
    for (int row0 = gw; row0 < MT + NMEMROWS; row0 += 4 * NGW) {
        f32x4 v[4][4];
#pragma unroll
        for (int q = 0; q < 4; ++q) {
            const int row = min(row0 + q * NGW, MT + NMEMROWS - 1);
            const float* src = row < MP ? p.x_prompt + (size_t)row * 1024 : (row < MT ? p.x_sample + (size_t)(row - MP) * 1024 : p.mem_prompt + (size_t)(row - MT) * 1024);
#pragma unroll
            for (int j = 0; j < 4; ++j) v[q][j] = ((const f32x4*)src)[lane + 64 * j];
        }
#pragma unroll
        for (int q = 0; q < 4; ++q) {
            const int row = row0 + q * NGW;
            float ss = 0.f;
#pragma unroll
            for (int j = 0; j < 4; ++j) ss += (v[q][j].x * v[q][j].x + v[q][j].y * v[q][j].y) + (v[q][j].z * v[q][j].z + v[q][j].w * v[q][j].w);
            const float r = rsqrtf(wave_sum(ss) * (1.f / 1024.f) + EPS);
            if (row < MT + NMEMROWS) {
                const float* gain = row < MT ? p.g_pre_mix : p.mem_norm_g;
                bf16_t* dst = row < MT ? XN + (size_t)row * 1024 : MN + (size_t)(row - MT) * 1024;
                u32x2* o8 = (u32x2*)dst + lane;
#pragma unroll
                for (int j = 0; j < 4; ++j) { const f32x4 g = ((const f32x4*)gain)[lane + 64 * j]; u32x2 o; o.x = pk2(v[q][j].x * r * g.x, v[q][j].y * r * g.y); o.y = pk2(v[q][j].z * r * g.z, v[q][j].w * r * g.w); o8[64 * j] = o; }
            }
        }
    }
}

template <int T>
__device__ __forceinline__ void conv_item(const Params& p, const bf16_t* U, bf16_t* C, LAS unsigned* cl, bool isP, int rowbase, int t0, int sb, int lane) {
    float s[T], s2[T];
#pragma unroll
    for (int t = 0; t < T; ++t) { s[t] = 0.f; s2[t] = 0.f; }
#pragma unroll 1
    for (int kq = 0; kq < 4; ++kq) {
        const int ch = kq * 128 + 2 * lane;
        float w0[T + 30], w1[T + 30];
#pragma unroll
        for (int r = 0; r < T + 30; ++r) {
            const int tr = t0 - 30 + r;
            if (tr >= 0) { const unsigned uu = *(const unsigned*)(U + (size_t)(rowbase + tr) * 512 + ch); w0[r] = bf_lo(uu); w1[r] = bf_hi(uu); }
            else if (isP) { w0[r] = 0.f; w1[r] = 0.f; }
            else { const f32x2 sv = *(const f32x2*)(p.state_conv + ((size_t)(sb * 30 + 30 + tr)) * 512 + ch); w0[r] = sv.x; w1[r] = sv.y; }
        }
        const f32x2 bias = *(const f32x2*)(p.conv_b + ch);
#pragma unroll
        for (int tg = 0; tg < T; tg += 8) {
            float a0[8], a1[8];
#pragma unroll
            for (int t = 0; t < 8; ++t) { a0[t] = bias.x; a1[t] = bias.y; }
#pragma unroll
            for (int j = 0; j < 31; ++j) {
                const f32x2 w = *(const f32x2*)(p.conv_w + j * 512 + ch);
#pragma unroll
                for (int t = 0; t < 8; ++t) { a0[t] += w.x * w0[tg + t + j]; a1[t] += w.y * w1[tg + t + j]; }
            }
#pragma unroll
            for (int t = 0; t < 8; ++t) { cl[(tg + t) * 256 + kq * 64 + lane] = pk2(a0[t], a1[t]); s[tg + t] += a0[t] + a1[t]; s2[tg + t] += a0[t] * a0[t] + a1[t] * a1[t]; }
            __builtin_amdgcn_sched_barrier(0);
        }
    }
    float mu[T], rstd[T];
#pragma unroll
    for (int t = 0; t < T; ++t) { const float a = wave_sum(s[t]), b = wave_sum(s2[t]); mu[t] = a * (1.f / 512.f); rstd[t] = rsqrtf(fmaxf(b * (1.f / 512.f) - mu[t] * mu[t], 0.f) + EPS); }
#pragma unroll 1
    for (int kq = 0; kq < 4; ++kq) {
        const int ch = kq * 128 + 2 * lane;
        const f32x2 g = *(const f32x2*)(p.ln_g + ch), bb = *(const f32x2*)(p.ln_b + ch);
#pragma unroll
        for (int t = 0; t < T; ++t) {
            const unsigned cv = cl[t * 256 + kq * 64 + lane];
            const float y0 = silu((bf_lo(cv) - mu[t]) * rstd[t] * g.x + bb.x), y1 = silu((bf_hi(cv) - mu[t]) * rstd[t] * g.y + bb.y);
            *(unsigned*)(C + (size_t)(rowbase + t0 + t) * 512 + ch) = pk2(y0, y1);
        }
    }
    LDS_WAIT();
}
template <int C0>
__device__ __forceinline__ void conv_chunk(float (&acc)[64], const float (&w)[31], const LAS unsigned short* win) {
    float x[46];
#pragma unroll
    for (int r = 0; r < 46; ++r) x[r] = bf2f(win[(C0 * 16 + r) * 512]);
#pragma unroll
    for (int i = 0; i < 16; ++i) {
        float a = acc[C0 * 16 + i];
#pragma unroll
        for (int j = 0; j < 31; ++j) a += w[j] * x[i + j];
        acc[C0 * 16 + i] = a;
    }
}
__device__ __forceinline__ void conv_prompt_block(const Params& p, LAS unsigned char* lds, int wave, int lane, int tid) {
    const bf16_t* U = (const bf16_t*)(p.ws + WS_U); bf16_t* C = (bf16_t*)(p.ws + WS_C);
    LAS float* part = (LAS float*)(lds + 96256);
    LAS float* fin = part + 4096;
    const int ch = tid;
    float w[31];
#pragma unroll
    for (int j = 0; j < 31; ++j) w[j] = p.conv_w[j * 512 + ch];
    const float bias = p.conv_b[ch], lg = p.ln_g[ch], lb = p.ln_b[ch];
    for (int it = blockIdx.x; it < 256; it += gridDim.x) {
        const int b = it >> 5, t0 = (it & 31) * 64, rowbase = b * 2048;
        {
            u32x4 cv[12];
#pragma unroll
            for (int i = 0; i < 12; ++i) {
                const int g = tid + 512 * i, row = g >> 6, c = g & 63, tr = t0 - 30 + row;
                cv[i] = (row < 94 && tr >= 0) ? *(const u32x4*)(U + (size_t)(rowbase + tr) * 512 + c * 8) : (u32x4){0u, 0u, 0u, 0u};
            }
#pragma unroll
            for (int i = 0; i < 12; ++i) { const int g = tid + 512 * i, row = g >> 6, c = g & 63; if (row < 94) *(LAS u32x4*)(lds + row * 1024 + c * 16) = cv[i]; }
        }
        __syncthreads();
        float acc[64];
#pragma unroll
        for (int t = 0; t < 64; ++t) acc[t] = bias;
        const LAS unsigned short* win = (const LAS unsigned short*)lds + ch;
        conv_chunk<0>(acc, w, win); conv_chunk<1>(acc, w, win); conv_chunk<2>(acc, w, win); conv_chunk<3>(acc, w, win);
#define ROWSUM(v) do { v += __int_as_float(__builtin_amdgcn_update_dpp(0, __float_as_int(v), 0x111, 0xf, 0xf, false)); v += __int_as_float(__builtin_amdgcn_update_dpp(0, __float_as_int(v), 0x112, 0xf, 0xf, false)); \
                       v += __int_as_float(__builtin_amdgcn_update_dpp(0, __float_as_int(v), 0x114, 0xf, 0xf, false)); v += __int_as_float(__builtin_amdgcn_update_dpp(0, __float_as_int(v), 0x118, 0xf, 0xf, false)); } while (0)
#pragma unroll
        for (int t = 0; t < 64; ++t) {
            float s1 = acc[t], s2 = acc[t] * acc[t];
            ROWSUM(s1); ROWSUM(s2);
            if ((lane & 15) == 15) *(LAS f32x2*)(part + ((wave * 4 + (lane >> 4)) * 64 + t) * 2) = (f32x2){s1, s2};
        }
#undef ROWSUM
        __syncthreads();
        if (tid < 64) {
            float s1 = 0.f, s2 = 0.f;
#pragma unroll
            for (int wv = 0; wv < 32; ++wv) { const f32x2 pv = *(const LAS f32x2*)(part + (wv * 64 + tid) * 2); s1 += pv.x; s2 += pv.y; }
            const float mu = s1 * (1.f / 512.f);
            fin[tid * 2] = mu; fin[tid * 2 + 1] = rsqrtf(fmaxf(s2 * (1.f / 512.f) - mu * mu, 0.f) + EPS);
        }
        __syncthreads();
#pragma unroll
        for (int t = 0; t < 64; ++t) {
            const f32x2 st = *(const LAS f32x2*)(fin + 2 * t);
            const float y = silu((acc[t] - st.x) * st.y * lg + lb);
            C[(size_t)(rowbase + t0 + t) * 512 + ch] = (bf16_t)(pk2(y, 0.f) & 0xffffu);
        }
        __syncthreads();
    }
}
__device__ __forceinline__ void conv_phase(const Params& p, LAS unsigned char* lds, int wave, int gw, int NGW, int lane) {
    const bf16_t* U = (const bf16_t*)(p.ws + WS_U); bf16_t* C = (bf16_t*)(p.ws + WS_C);
    LAS unsigned* cl = (LAS unsigned*)(lds + wave * 16384);
    for (int sb = (gw + NGW - 1024) % NGW; sb < 128; sb += NGW) conv_item<8>(p, U, C, cl, false, MP + sb * 8, 0, sb, lane);
}
__device__ __forceinline__ void convstate_phase(const Params& p, int gtid, int NT) {
    const bf16_t* U = (const bf16_t*)(p.ws + WS_U);
    float* op = p.out + O_CONVP; float* os = p.out + O_CONVS;
    for (int idx = gtid; idx < (8 + 128) * 30 * 64; idx += NT) {
        const int c8 = (idx & 63) * 8, r = idx >> 6;
        f32x4 a, b;
        if (r < 240) { const int i = r % 30, bb = r / 30;
            const u32x4 u = *(const u32x4*)(U + (size_t)(bb * 2048 + 2018 + i) * 512 + c8);
            a = (f32x4){bf_lo(u.x), bf_hi(u.x), bf_lo(u.y), bf_hi(u.y)}; b = (f32x4){bf_lo(u.z), bf_hi(u.z), bf_lo(u.w), bf_hi(u.w)};
            float* o = op + (size_t)r * 512 + c8; *(f32x4*)o = a; *(f32x4*)(o + 4) = b;
        } else { const int rs = r - 240, i = rs % 30, sb = rs / 30;
            if (i < 22) { const float* sp = p.state_conv + ((size_t)(sb * 30 + 8 + i)) * 512 + c8; a = *(const f32x4*)sp; b = *(const f32x4*)(sp + 4); }
            else { const u32x4 u = *(const u32x4*)(U + (size_t)(MP + sb * 8 + i - 22) * 512 + c8);
                a = (f32x4){bf_lo(u.x), bf_hi(u.x), bf_lo(u.y), bf_hi(u.y)}; b = (f32x4){bf_lo(u.z), bf_hi(u.z), bf_lo(u.w), bf_hi(u.w)}; }
            float* o = os + (size_t)rs * 512 + c8; *(f32x4*)o = a; *(f32x4*)(o + 4) = b;
        }
    }
}
template <int NT_>
__device__ __forceinline__ void attn_item(const bf16_t* MQ, const bf16_t* KB, const bf16_t* VT, bf16_t* OM, int kvb, int h, int row0, int nvalid, int l15, int quad) {
    bf16x8 qf[NT_][4];
#pragma unroll
    for (int t = 0; t < NT_; ++t) {
        const int qrow = row0 + t * 16 + (l15 < nvalid ? l15 : nvalid - 1);
#pragma unroll
        for (int kk = 0; kk < 4; ++kk) qf[t][kk] = *(const bf16x8*)(MQ + (size_t)qrow * 512 + h * 128 + kk * 32 + quad * 8);
    }
    const bf16_t* Kb = KB + ((size_t)(kvb * 4 + h) * 256) * 128 + (size_t)l15 * 128 + quad * 8;
    f32x4 s[NT_][16];
#pragma unroll
    for (int kq = 0; kq < 16; kq += 4) {
        bf16x8 kf[4][4];
#pragma unroll
        for (int u = 0; u < 4; ++u)
#pragma unroll
            for (int kk = 0; kk < 4; ++kk) kf[u][kk] = *(const bf16x8*)(Kb + (size_t)((kq + u) * 16) * 128 + kk * 32);
        __builtin_amdgcn_sched_barrier(0);
#pragma unroll
        for (int u = 0; u < 4; ++u) {
#pragma unroll
            for (int t = 0; t < NT_; ++t) s[t][kq + u] = (f32x4){0.f, 0.f, 0.f, 0.f};
#pragma unroll
            for (int kk = 0; kk < 4; ++kk)
#pragma unroll
                for (int t = 0; t < NT_; ++t) s[t][kq + u] = __builtin_amdgcn_mfma_f32_16x16x32_bf16(kf[u][kk], qf[t][kk], s[t][kq + u], 0, 0, 0);
        }
        __builtin_amdgcn_sched_barrier(0);
    }
    float inv[NT_];
    bf16x8 pf[NT_][8];
#pragma unroll
    for (int t = 0; t < NT_; ++t) {
        float mx = -3.0e38f;
#pragma unroll
        for (int kt = 0; kt < 16; ++kt) mx = fmaxf(fmaxf(fmaxf(s[t][kt][0], s[t][kt][1]), fmaxf(s[t][kt][2], s[t][kt][3])), mx);
        mx = fmaxf(mx, __shfl_xor(mx, 16)); mx = fmaxf(mx, __shfl_xor(mx, 32));
        float sum = 0.f;
#pragma unroll
        for (int kt = 0; kt < 16; ++kt)
#pragma unroll
            for (int i = 0; i < 4; ++i) { const float e = __builtin_amdgcn_exp2f(s[t][kt][i] - mx); s[t][kt][i] = e; sum += e; }
        sum += __shfl_xor(sum, 16); sum += __shfl_xor(sum, 32);
        inv[t] = __builtin_amdgcn_rcpf(sum);
#pragma unroll
        for (int kb = 0; kb < 8; ++kb) {
            u32x4 pu; pu.x = pk2(s[t][2 * kb][0], s[t][2 * kb][1]); pu.y = pk2(s[t][2 * kb][2], s[t][2 * kb][3]); pu.z = pk2(s[t][2 * kb + 1][0], s[t][2 * kb + 1][1]); pu.w = pk2(s[t][2 * kb + 1][2], s[t][2 * kb + 1][3]);
            pf[t][kb] = __builtin_bit_cast(bf16x8, pu);
        }
    }
    const bf16_t* Vb = VT + ((size_t)(kvb * 4 + h) * 128) * 256 + (size_t)l15 * 256 + quad * 8;
    f32x4 o[NT_][8];
#pragma unroll
    for (int t = 0; t < NT_; ++t)
#pragma unroll
        for (int vt = 0; vt < 8; ++vt) o[t][vt] = (f32x4){0.f, 0.f, 0.f, 0.f};
#pragma unroll
    for (int kb2 = 0; kb2 < 8; kb2 += 2) {
        bf16x8 vf[2][8];
#pragma unroll
        for (int u = 0; u < 2; ++u)
#pragma unroll
            for (int vt = 0; vt < 8; ++vt) vf[u][vt] = *(const bf16x8*)(Vb + (size_t)(vt * 16) * 256 + (kb2 + u) * 32);
        __builtin_amdgcn_sched_barrier(0);
#pragma unroll
        for (int u = 0; u < 2; ++u)
#pragma unroll
            for (int vt = 0; vt < 8; ++vt)
#pragma unroll
                for (int t = 0; t < NT_; ++t) o[t][vt] = __builtin_amdgcn_mfma_f32_16x16x32_bf16(vf[u][vt], pf[t][kb2 + u], o[t][vt], 0, 0, 0);
        __builtin_amdgcn_sched_barrier(0);
    }
    if (l15 < nvalid) {
#pragma unroll
        for (int t = 0; t < NT_; ++t) {
            bf16_t* op = OM + (size_t)(row0 + t * 16 + l15) * 512 + h * 128 + quad * 4;
#pragma unroll
            for (int vt = 0; vt < 8; ++vt) { u32x2 w; w.x = pk2(o[t][vt][0] * inv[t], o[t][vt][1] * inv[t]); w.y = pk2(o[t][vt][2] * inv[t], o[t][vt][3] * inv[t]); *(u32x2*)(op + vt * 16) = w; }
        }
    }
}
__device__ __forceinline__ void attn_sample_block(const Params& p, LAS unsigned char* lds, int wave, int lane) {
    const bf16_t* MQ = (const bf16_t*)(p.ws + WS_MQ); bf16_t* OM = (bf16_t*)(p.ws + WS_OM);
    const int l15 = lane & 15, quad = lane >> 4;
    LAS float* Pl = (LAS float*)(lds + wave * 16384);
    LAS float* Ow = Pl + 256;
    LAS float* St = Pl + 256 + 1024;
    for (int it = blockIdx.x; it < 512; it += gridDim.x) {
        const int sb = it >> 2, h = it & 3, row0 = MP + sb * 8, key0 = wave * 32;
        bf16x8 qf[4];
#pragma unroll
        for (int kk = 0; kk < 4; ++kk) qf[kk] = *(const bf16x8*)(MQ + (size_t)(row0 + (l15 & 7)) * 512 + h * 128 + kk * 32 + quad * 8);
        const float* Kc = p.cache_k + ((size_t)sb * 256 * 4 + h) * 128 + (size_t)(key0 + l15) * 512 + quad * 8;
        const float* Vc = p.cache_v + ((size_t)sb * 256 * 4 + h) * 128 + (size_t)key0 * 512 + 2 * lane;
        f32x4 ka[2][4], kb[2][4]; f32x2 vv[32];
#pragma unroll
        for (int u = 0; u < 2; ++u)
#pragma unroll
            for (int kk = 0; kk < 4; ++kk) { ka[u][kk] = __builtin_nontemporal_load((const f32x4*)(Kc + (size_t)u * 16 * 512 + kk * 32)); kb[u][kk] = __builtin_nontemporal_load((const f32x4*)(Kc + (size_t)u * 16 * 512 + kk * 32 + 4)); }
#pragma unroll
        for (int k = 0; k < 32; ++k) vv[k] = __builtin_nontemporal_load((const f32x2*)(Vc + (size_t)k * 512));
        f32x4 s[2];
#pragma unroll
        for (int u = 0; u < 2; ++u) {
            s[u] = (f32x4){0.f, 0.f, 0.f, 0.f};
#pragma unroll
            for (int kk = 0; kk < 4; ++kk) {
                u32x4 au; au.x = pk2(ka[u][kk].x, ka[u][kk].y); au.y = pk2(ka[u][kk].z, ka[u][kk].w); au.z = pk2(kb[u][kk].x, kb[u][kk].y); au.w = pk2(kb[u][kk].z, kb[u][kk].w);
                s[u] = __builtin_amdgcn_mfma_f32_16x16x32_bf16(__builtin_bit_cast(bf16x8, au), qf[kk], s[u], 0, 0, 0);
            }
        }
        float mx = fmaxf(fmaxf(fmaxf(s[0][0], s[0][1]), fmaxf(s[0][2], s[0][3])), fmaxf(fmaxf(s[1][0], s[1][1]), fmaxf(s[1][2], s[1][3])));
        mx = fmaxf(mx, __shfl_xor(mx, 16)); mx = fmaxf(mx, __shfl_xor(mx, 32));
        float sum = 0.f;
#pragma unroll
        for (int u = 0; u < 2; ++u)
#pragma unroll
            for (int i = 0; i < 4; ++i) { const float e = __builtin_amdgcn_exp2f(s[u][i] - mx); s[u][i] = e; sum += e; }
        sum += __shfl_xor(sum, 16); sum += __shfl_xor(sum, 32);
        if (l15 < 8) {
#pragma unroll
            for (int u = 0; u < 2; ++u)
#pragma unroll
                for (int i = 0; i < 4; ++i) Pl[(u * 16 + quad * 4 + i) * 8 + l15] = s[u][i];
            if (quad == 0) { St[l15] = mx; St[8 + l15] = sum; }
        }
        LDS_WAIT();
        float o0[8], o1[8];
#pragma unroll
        for (int q = 0; q < 8; ++q) { o0[q] = 0.f; o1[q] = 0.f; }
#pragma unroll
        for (int k = 0; k < 32; ++k) {
            const f32x4 pa = *(const LAS f32x4*)(Pl + k * 8), pb = *(const LAS f32x4*)(Pl + k * 8 + 4);
            o0[0] += pa.x * vv[k].x; o1[0] += pa.x * vv[k].y; o0[1] += pa.y * vv[k].x; o1[1] += pa.y * vv[k].y;
            o0[2] += pa.z * vv[k].x; o1[2] += pa.z * vv[k].y; o0[3] += pa.w * vv[k].x; o1[3] += pa.w * vv[k].y;
            o0[4] += pb.x * vv[k].x; o1[4] += pb.x * vv[k].y; o0[5] += pb.y * vv[k].x; o1[5] += pb.y * vv[k].y;
            o0[6] += pb.z * vv[k].x; o1[6] += pb.z * vv[k].y; o0[7] += pb.w * vv[k].x; o1[7] += pb.w * vv[k].y;
        }
#pragma unroll
        for (int q = 0; q < 8; ++q) *(LAS f32x2*)(Ow + q * 128 + 2 * lane) = (f32x2){o0[q], o1[q]};
        __syncthreads();
        {
            const int q = wave;
            float mw[8], M = -3.0e38f;
#pragma unroll
            for (int w = 0; w < 8; ++w) { mw[w] = ((const LAS float*)(lds + w * 16384))[256 + 1024 + q]; M = fmaxf(M, mw[w]); }
            float den = 0.f, a0 = 0.f, a1 = 0.f;
#pragma unroll
            for (int w = 0; w < 8; ++w) {
                const LAS float* base = (const LAS float*)(lds + w * 16384);
                const float sc = __builtin_amdgcn_exp2f(mw[w] - M);
                den += sc * base[256 + 1024 + 8 + q];
                const f32x2 ov = *(const LAS f32x2*)(base + 256 + q * 128 + 2 * lane);
                a0 += sc * ov.x; a1 += sc * ov.y;
            }
            const float inv = __builtin_amdgcn_rcpf(den);
            *(unsigned*)(OM + (size_t)(row0 + q) * 512 + h * 128 + 2 * lane) = pk2(a0 * inv, a1 * inv);
        }
        __syncthreads();
    }
}
__device__ __forceinline__ void attn_prompt_block(const Params& p, LAS unsigned char* lds, int wave, int lane, int tid) {
    const bf16_t* MQ = (const bf16_t*)(p.ws + WS_MQ); const bf16_t* KB = (const bf16_t*)(p.ws + WS_KB); const bf16_t* VT = (const bf16_t*)(p.ws + WS_VT);
    bf16_t* OM = (bf16_t*)(p.ws + WS_OM);
    const int l15 = lane & 15, quad = lane >> 4;
    for (int grp = blockIdx.x; grp < 256; grp += gridDim.x) {
        const int kvb = grp >> 5, h = (grp >> 3) & 3, row0 = kvb * 2048 + (grp & 7) * 256 + wave * 32;
        {
            const u32x4* kg = (const u32x4*)(KB + ((size_t)(kvb * 4 + h) * 256) * 128);
            const u32x4* vg = (const u32x4*)(VT + ((size_t)(kvb * 4 + h) * 128) * 256);
            u32x4 kc[8], vc[8];
#pragma unroll
            for (int i = 0; i < 8; ++i) { kc[i] = kg[tid + 512 * i]; vc[i] = vg[tid + 512 * i]; }
#pragma unroll
            for (int i = 0; i < 8; ++i) {
                const int g = tid + 512 * i;
                const int kr = g >> 4, kcn = g & 15; *(LAS u32x4*)(lds + kr * 256 + ((kcn ^ (kr & 15)) << 4)) = kc[i];
                const int vr = g >> 5, vcn = g & 31; *(LAS u32x4*)(lds + 65536 + vr * 512 + ((vcn ^ (vr & 15)) << 4)) = vc[i];
            }
        }
        bf16x8 qf[2][4];
#pragma unroll
        for (int t = 0; t < 2; ++t)
#pragma unroll
            for (int kk = 0; kk < 4; ++kk) qf[t][kk] = *(const bf16x8*)(MQ + (size_t)(row0 + t * 16 + l15) * 512 + h * 128 + kk * 32 + quad * 8);
        __syncthreads();
        f32x4 s[2][16];
#pragma unroll
        for (int kt = 0; kt < 16; ++kt) {
            s[0][kt] = (f32x4){0.f, 0.f, 0.f, 0.f}; s[1][kt] = (f32x4){0.f, 0.f, 0.f, 0.f};
#pragma unroll
            for (int kk = 0; kk < 4; ++kk) {
                const bf16x8 a = *(const LAS bf16x8*)(lds + (kt * 16 + l15) * 256 + (((kk * 4 + quad) ^ l15) << 4));
                s[0][kt] = __builtin_amdgcn_mfma_f32_16x16x32_bf16(a, qf[0][kk], s[0][kt], 0, 0, 0);
                s[1][kt] = __builtin_amdgcn_mfma_f32_16x16x32_bf16(a, qf[1][kk], s[1][kt], 0, 0, 0);
            }
        }
        float inv[2]; bf16x8 pf[2][8];
#pragma unroll
        for (int t = 0; t < 2; ++t) {
            float mx = -3.0e38f;
#pragma unroll
            for (int kt = 0; kt < 16; ++kt) mx = fmaxf(fmaxf(fmaxf(s[t][kt][0], s[t][kt][1]), fmaxf(s[t][kt][2], s[t][kt][3])), mx);
            mx = fmaxf(mx, __shfl_xor(mx, 16)); mx = fmaxf(mx, __shfl_xor(mx, 32));
            float sum = 0.f;
#pragma unroll
            for (int kt = 0; kt < 16; ++kt)
#pragma unroll
                for (int i = 0; i < 4; ++i) { const float e = __builtin_amdgcn_exp2f(s[t][kt][i] - mx); s[t][kt][i] = e; sum += e; }
            sum += __shfl_xor(sum, 16); sum += __shfl_xor(sum, 32);
            inv[t] = __builtin_amdgcn_rcpf(sum);
#pragma unroll
            for (int kb = 0; kb < 8; ++kb) {
                u32x4 pu; pu.x = pk2(s[t][2 * kb][0], s[t][2 * kb][1]); pu.y = pk2(s[t][2 * kb][2], s[t][2 * kb][3]); pu.z = pk2(s[t][2 * kb + 1][0], s[t][2 * kb + 1][1]); pu.w = pk2(s[t][2 * kb + 1][2], s[t][2 * kb + 1][3]);
                pf[t][kb] = __builtin_bit_cast(bf16x8, pu);
            }
        }
        f32x4 o[2][8];
#pragma unroll
        for (int t = 0; t < 2; ++t)
#pragma unroll
            for (int vt = 0; vt < 8; ++vt) o[t][vt] = (f32x4){0.f, 0.f, 0.f, 0.f};
#pragma unroll
        for (int kb = 0; kb < 8; ++kb)
#pragma unroll
            for (int vt = 0; vt < 8; ++vt) {
                const bf16x8 a = *(const LAS bf16x8*)(lds + 65536 + (vt * 16 + l15) * 512 + (((kb * 4 + quad) ^ l15) << 4));
                o[0][vt] = __builtin_amdgcn_mfma_f32_16x16x32_bf16(a, pf[0][kb], o[0][vt], 0, 0, 0);
                o[1][vt] = __builtin_amdgcn_mfma_f32_16x16x32_bf16(a, pf[1][kb], o[1][vt], 0, 0, 0);
            }
#pragma unroll
        for (int t = 0; t < 2; ++t) {
            bf16_t* op = OM + (size_t)(row0 + t * 16 + l15) * 512 + h * 128 + quad * 4;
#pragma unroll
            for (int vt = 0; vt < 8; ++vt) { u32x2 w; w.x = pk2(o[t][vt][0] * inv[t], o[t][vt][1] * inv[t]); w.y = pk2(o[t][vt][2] * inv[t], o[t][vt][3] * inv[t]); *(u32x2*)(op + vt * 16) = w; }
        }
        __syncthreads();
    }
}
__device__ __forceinline__ void hg1_phase(const Params& p, int gw, int NGW, int lane) {
    const bf16_t* KE = (const bf16_t*)(p.ws + WS_KE); const bf16_t* VV = (const bf16_t*)(p.ws + WS_VV); const float* DEC = (const float*)(p.ws + WS_DEC);
    bf16_t* KVT = (bf16_t*)(p.out + O_Y);
    const int l15 = lane & 15, quad = lane >> 4;
    for (int itv_ = gw; itv_ < HG1_END * REP_M; itv_ += NGW) { const int item = itv_ % HG1_END;
        const bool isP = item < 2048;
        int rowbase, h, bh;
        if (isP) { bh = item >> 6; h = bh & 3; rowbase = (bh >> 2) * 2048 + (item & 63) * 32; } else { const int s = item - 2048; bh = s; h = s & 3; rowbase = MP + (s >> 2) * 8; }
        const unsigned short lm = (isP || quad == 0) ? (unsigned short)0xffffu : (unsigned short)0u;
        const size_t base = (size_t)(isP ? rowbase + quad * 8 : rowbase) * 512 + h * 128 + l15;
        bf16x8 BF[8];
#pragma unroll
        for (int vt = 0; vt < 8; ++vt)
#pragma unroll
            for (int j = 0; j < 8; ++j) BF[vt][j] = (short)(VV[base + (size_t)j * 512 + vt * 16] & lm);
        bf16x8 AF[8];
#pragma unroll
        for (int dt = 0; dt < 8; ++dt)
#pragma unroll
            for (int j = 0; j < 8; ++j) AF[dt][j] = (short)(KE[base + (size_t)j * 512 + dt * 16] & lm);
        __builtin_amdgcn_sched_barrier(0);
        if (isP) {
#pragma unroll
            for (int dt = 0; dt < 8; ++dt)
#pragma unroll
                for (int vt = 0; vt < 8; ++vt) {
                    const f32x4 a = __builtin_amdgcn_mfma_f32_16x16x32_bf16(AF[dt], BF[vt], (f32x4){0.f, 0.f, 0.f, 0.f}, 0, 0, 0);
                    u32x2 w; w.x = pk2(a[0], a[1]); w.y = pk2(a[2], a[3]);
                    *(u32x2*)(KVT + ((size_t)item * 128 + vt * 16 + l15) * 128 + dt * 16 + quad * 4) = w;
                }
        } else {
#pragma unroll
            for (int dt = 0; dt < 8; ++dt) {
                const int d = dt * 16 + l15;
                const float dec = DEC[(size_t)item * 128 + d];
                const size_t so = ((size_t)bh * 128 + d) * 128 + quad * 4;
                f32x4 s0[8];
#pragma unroll
                for (int vt = 0; vt < 8; ++vt) s0[vt] = *(const f32x4*)(p.state_hgrn + so + vt * 16);
#pragma unroll
                for (int vt = 0; vt < 8; ++vt) {
                    const f32x4 a = __builtin_amdgcn_mfma_f32_16x16x32_bf16(BF[vt], AF[dt], (f32x4){0.f, 0.f, 0.f, 0.f}, 0, 0, 0);
                    *(f32x4*)(p.out + O_HGS + so + vt * 16) = s0[vt] * dec + a;
                }
                __builtin_amdgcn_sched_barrier(0);
            }
        }
    }
}
__device__ __forceinline__ void hg2_phase(const Params& p, int gtid, int NT) {
    bf16_t* KVT = (bf16_t*)(p.out + O_Y); const float* DEC = (const float*)(p.ws + WS_DEC);
    for (int g = gtid; g < 131072; g += NT) {
        const int bh = g >> 12, v = (g >> 5) & 127, d = (g & 31) * 4;
        f32x4 S = (f32x4){0.f, 0.f, 0.f, 0.f};
#pragma unroll 1
        for (int n0 = 0; n0 < 64; n0 += 8) {
            u32x2 kv[8]; f32x4 dec[8];
#pragma unroll
            for (int k = 0; k < 8; ++k) {
                const int item = bh * 64 + n0 + k;
                kv[k] = *(const u32x2*)(KVT + ((size_t)item * 128 + v) * 128 + d); dec[k] = *(const f32x4*)(DEC + (size_t)item * 128 + d);
            }
#pragma unroll
            for (int k = 0; k < 8; ++k) {
                const int item = bh * 64 + n0 + k;
                u32x2 w; w.x = pk2(S[0], S[1]); w.y = pk2(S[2], S[3]); *(u32x2*)(KVT + ((size_t)item * 128 + v) * 128 + d) = w;
                S[0] = dec[k][0] * S[0] + bf_lo(kv[k].x); S[1] = dec[k][1] * S[1] + bf_hi(kv[k].x); S[2] = dec[k][2] * S[2] + bf_lo(kv[k].y); S[3] = dec[k][3] * S[3] + bf_hi(kv[k].y);
            }
        }
        float* o = p.out + O_HGP + ((size_t)bh * 128 + d) * 128 + v;
#pragma unroll
        for (int i = 0; i < 4; ++i) o[(size_t)i * 128] = S[i];
    }
}
__device__ __forceinline__ void hg3_phase(const Params& p, int gw, int NGW, int lane) {
    const bf16_t* QD = (const bf16_t*)(p.ws + WS_QD); const bf16_t* KI = (const bf16_t*)(p.ws + WS_KI); const bf16_t* VV = (const bf16_t*)(p.ws + WS_VV);
    const bf16_t* HGT = (const bf16_t*)(p.ws + WS_HGT); const bf16_t* ST = (const bf16_t*)(p.out + O_Y);
    bf16_t* OG = (bf16_t*)(p.ws + WS_KE);
    const int l15 = lane & 15, quad = lane >> 4;
    for (int itv_ = gw; itv_ < 2560 * REP_M; itv_ += NGW) { const int item = itv_ % 2560;
        const bool isP = item < 2048;
        int rowbase, h, bh;
        if (isP) { bh = item >> 6; h = bh & 3; rowbase = (bh >> 2) * 2048 + (item & 63) * 32; } else { const int s = item - 2048; bh = s; h = s & 3; rowbase = MP + (s >> 2) * 8; }
        const int col0 = h * 128;
        const int r0 = min(rowbase + l15, MT - 1), r1 = min(rowbase + 16 + l15, MT - 1);
        bf16x8 qb[2][4], ka[2][4];
#pragma unroll
        for (int kk = 0; kk < 4; ++kk) {
            qb[0][kk] = *(const bf16x8*)(QD + (size_t)r0 * 512 + col0 + kk * 32 + quad * 8); qb[1][kk] = *(const bf16x8*)(QD + (size_t)r1 * 512 + col0 + kk * 32 + quad * 8);
            ka[0][kk] = *(const bf16x8*)(KI + (size_t)r0 * 512 + col0 + kk * 32 + quad * 8); ka[1][kk] = *(const bf16x8*)(KI + (size_t)r1 * 512 + col0 + kk * 32 + quad * 8);
        }
        f32x4 s00 = (f32x4){0.f, 0.f, 0.f, 0.f}, s01 = s00, s11 = s00;
#pragma unroll
        for (int kk = 0; kk < 4; ++kk) {
            s00 = __builtin_amdgcn_mfma_f32_16x16x32_bf16(ka[0][kk], qb[0][kk], s00, 0, 0, 0);
            s01 = __builtin_amdgcn_mfma_f32_16x16x32_bf16(ka[0][kk], qb[1][kk], s01, 0, 0, 0);
            s11 = __builtin_amdgcn_mfma_f32_16x16x32_bf16(ka[1][kk], qb[1][kk], s11, 0, 0, 0);
        }
#pragma unroll
        for (int r = 0; r < 4; ++r) { const int sl = quad * 4 + r; if (sl > l15) { s00[r] = 0.f; s11[r] = 0.f; } }
        u32x4 pu;
        pu.x = pk2(s00[0], s00[1]); pu.y = pk2(s00[2], s00[3]); pu.z = 0u; pu.w = 0u; const bf16x8 pf0 = __builtin_bit_cast(bf16x8, pu);
        pu.x = pk2(s01[0], s01[1]); pu.y = pk2(s01[2], s01[3]); pu.z = pk2(s11[0], s11[1]); pu.w = pk2(s11[2], s11[3]); const bf16x8 pf1 = __builtin_bit_cast(bf16x8, pu);
        f32x4 o[8][2];
#pragma unroll
        for (int vt = 0; vt < 8; ++vt) {
            bf16x8 vf;
#pragma unroll
            for (int j = 0; j < 8; ++j) { const int sl = j < 4 ? quad * 4 + j : 16 + quad * 4 + (j - 4); vf[j] = (short)VV[(size_t)min(rowbase + sl, MT - 1) * 512 + col0 + vt * 16 + l15]; }
            o[vt][0] = __builtin_amdgcn_mfma_f32_16x16x32_bf16(vf, pf0, (f32x4){0.f, 0.f, 0.f, 0.f}, 0, 0, 0);
            o[vt][1] = __builtin_amdgcn_mfma_f32_16x16x32_bf16(vf, pf1, (f32x4){0.f, 0.f, 0.f, 0.f}, 0, 0, 0);
        }
        {
            const float* S0 = p.state_hgrn + (size_t)bh * 16384;
#pragma unroll 1
            for (int kk = 0; kk < 4; ++kk) {
                const bf16x8 q0 = *(const bf16x8*)(QD + (size_t)r0 * 512 + col0 + kk * 32 + quad * 8);
                if (isP) {
                    const bf16x8 q1 = *(const bf16x8*)(QD + (size_t)r1 * 512 + col0 + kk * 32 + quad * 8);
#pragma unroll
                    for (int vt = 0; vt < 8; ++vt) {
                        const bf16x8 a = *(const bf16x8*)(ST + ((size_t)item * 128 + vt * 16 + l15) * 128 + kk * 32 + quad * 8);
                        o[vt][0] = __builtin_amdgcn_mfma_f32_16x16x32_bf16(a, q0, o[vt][0], 0, 0, 0);
                        o[vt][1] = __builtin_amdgcn_mfma_f32_16x16x32_bf16(a, q1, o[vt][1], 0, 0, 0);
                    }
                } else {
#pragma unroll
                    for (int vt = 0; vt < 8; ++vt) {
                        float sv[8];
#pragma unroll
                        for (int j = 0; j < 8; ++j) sv[j] = S0[(size_t)(kk * 32 + quad * 8 + j) * 128 + vt * 16 + l15];
                        u32x4 au; au.x = pk2(sv[0], sv[1]); au.y = pk2(sv[2], sv[3]); au.z = pk2(sv[4], sv[5]); au.w = pk2(sv[6], sv[7]);
                        o[vt][0] = __builtin_amdgcn_mfma_f32_16x16x32_bf16(__builtin_bit_cast(bf16x8, au), q0, o[vt][0], 0, 0, 0);
                    }
                }
            }
        }
#pragma unroll
        for (int tt = 0; tt < 2; ++tt) {
            float ss = 0.f;
#pragma unroll
            for (int vt = 0; vt < 8; ++vt) ss += (o[vt][tt][0] * o[vt][tt][0] + o[vt][tt][1] * o[vt][tt][1]) + (o[vt][tt][2] * o[vt][tt][2] + o[vt][tt][3] * o[vt][tt][3]);
            ss += __shfl_xor(ss, 16); ss += __shfl_xor(ss, 32);
            const float rn = rsqrtf(ss * (1.f / 128.f) + EPS);
            const bool valid = isP || (tt == 0 && l15 < 8);
            if (valid) {
                const size_t ro = (size_t)(rowbase + tt * 16 + l15) * 512 + col0 + quad * 4;
#pragma unroll
                for (int vt = 0; vt < 8; ++vt) {
                    const f32x4 g = *(const f32x4*)(p.hg_norm_g + vt * 16 + quad * 4);
                    const u32x2 gt = *(const u32x2*)(HGT + ro + vt * 16);
                    u32x2 w; w.x = pk2(o[vt][tt][0] * rn * g[0] * bf_lo(gt.x), o[vt][tt][1] * rn * g[1] * bf_hi(gt.x));
                    w.y = pk2(o[vt][tt][2] * rn * g[2] * bf_lo(gt.y), o[vt][tt][3] * rn * g[3] * bf_hi(gt.y));
                    *(u32x2*)(OG + ro + vt * 16) = w;
                }
            }
        }
    }
}

__device__ __forceinline__ void load_row8(const bf16_t* O, const float* P, int row, int j, int lane, float (&v)[8]) {
    if (row < MP) {
        const u32x4 u = *((const u32x4*)(O + (size_t)row * 1024) + lane + 64 * j);
        v[0] = bf_lo(u.x); v[1] = bf_hi(u.x); v[2] = bf_lo(u.y); v[3] = bf_hi(u.y); v[4] = bf_lo(u.z); v[5] = bf_hi(u.z); v[6] = bf_lo(u.w); v[7] = bf_hi(u.w);
    } else {
        const float* pp = P + (size_t)(row - MP) * 1024 + 512 * j + 8 * lane;
        f32x4 a = *(const f32x4*)pp, b = *(const f32x4*)(pp + 4);
#pragma unroll
        for (int q = 1; q < 4; ++q) { a += *(const f32x4*)(pp + (size_t)q * 1024 * 1024); b += *(const f32x4*)(pp + (size_t)q * 1024 * 1024 + 4); }
        v[0] = a.x; v[1] = a.y; v[2] = a.z; v[3] = a.w; v[4] = b.x; v[5] = b.y; v[6] = b.z; v[7] = b.w;
    }
}
__device__ __forceinline__ void rowpass1(const Params& p, int gw, int NGW, int lane) {
    const bf16_t* MO = (const bf16_t*)(p.ws + WS_VT); bf16_t* H2 = (bf16_t*)(p.ws + WS_XN); const float* PART = (const float*)(p.ws + WS_PART);
    for (int rowa = gw; rowa < MT; rowa += 2 * NGW) {
        float m[2][2][8], x[2][2][8]; float ss[2] = {0.f, 0.f};
#pragma unroll
        for (int q = 0; q < 2; ++q) {
            const int row = min(rowa + q * NGW, MT - 1);
            const float* xr = row < MP ? p.x_prompt + (size_t)row * 1024 : p.x_sample + (size_t)(row - MP) * 1024;
#pragma unroll
            for (int j = 0; j < 2; ++j) {
                load_row8(MO, PART, row, j, lane, m[q][j]);
                const f32x4 a = *(const f32x4*)(xr + 512 * j + 8 * lane), b = *(const f32x4*)(xr + 512 * j + 8 * lane + 4);
                x[q][j][0] = a.x; x[q][j][1] = a.y; x[q][j][2] = a.z; x[q][j][3] = a.w; x[q][j][4] = b.x; x[q][j][5] = b.y; x[q][j][6] = b.z; x[q][j][7] = b.w;
            }
        }
#pragma unroll
        for (int q = 0; q < 2; ++q)
#pragma unroll
            for (int j = 0; j < 2; ++j)
#pragma unroll
                for (int e = 0; e < 8; ++e) ss[q] += m[q][j][e] * m[q][j][e];
        float r1[2], s2[2] = {0.f, 0.f}, r2[2];
#pragma unroll
        for (int q = 0; q < 2; ++q) r1[q] = rsqrtf(wave_sum(ss[q]) * (1.f / 1024.f) + EPS);
#pragma unroll
        for (int j = 0; j < 2; ++j) {
            const f32x4 ga = *(const f32x4*)(p.g_post_mix + 512 * j + 8 * lane), gb = *(const f32x4*)(p.g_post_mix + 512 * j + 8 * lane + 4);
            const float g[8] = {ga.x, ga.y, ga.z, ga.w, gb.x, gb.y, gb.z, gb.w};
#pragma unroll
            for (int q = 0; q < 2; ++q)
#pragma unroll
                for (int e = 0; e < 8; ++e) { x[q][j][e] += m[q][j][e] * r1[q] * g[e]; s2[q] += x[q][j][e] * x[q][j][e]; }
        }
#pragma unroll
        for (int q = 0; q < 2; ++q) r2[q] = rsqrtf(wave_sum(s2[q]) * (1.f / 1024.f) + EPS);
#pragma unroll
        for (int q = 0; q < 2; ++q) {
            const int row = rowa + q * NGW;
            if (row < MT) {
                float* orow = p.out + O_Y + (size_t)row * 1024;
#pragma unroll
                for (int j = 0; j < 2; ++j) {
                    *(f32x4*)(orow + 512 * j + 8 * lane) = (f32x4){x[q][j][0], x[q][j][1], x[q][j][2], x[q][j][3]};
                    *(f32x4*)(orow + 512 * j + 8 * lane + 4) = (f32x4){x[q][j][4], x[q][j][5], x[q][j][6], x[q][j][7]};
                    const f32x4 ga = *(const f32x4*)(p.g_pre_ffn + 512 * j + 8 * lane), gb = *(const f32x4*)(p.g_pre_ffn + 512 * j + 8 * lane + 4);
                    u32x4 o; o.x = pk2(x[q][j][0] * r2[q] * ga.x, x[q][j][1] * r2[q] * ga.y); o.y = pk2(x[q][j][2] * r2[q] * ga.z, x[q][j][3] * r2[q] * ga.w);
                    o.z = pk2(x[q][j][4] * r2[q] * gb.x, x[q][j][5] * r2[q] * gb.y); o.w = pk2(x[q][j][6] * r2[q] * gb.z, x[q][j][7] * r2[q] * gb.w);
                    *((u32x4*)(H2 + (size_t)row * 1024) + lane + 64 * j) = o;
                }
            }
        }
    }
}
__device__ __forceinline__ void rowpass2(const Params& p, int gw, int NGW, int lane) {
    const bf16_t* FO = (const bf16_t*)(p.ws + WS_KB); const float* PART = (const float*)(p.ws + WS_PART);
    for (int rowa = gw; rowa < MT; rowa += 2 * NGW) {
        float f[2][2][8]; f32x4 xa[2][2], xb[2][2]; float ss[2] = {0.f, 0.f};
#pragma unroll
        for (int q = 0; q < 2; ++q) {
            const int row = min(rowa + q * NGW, MT - 1);
            const float* orow = p.out + O_Y + (size_t)row * 1024;
#pragma unroll
            for (int j = 0; j < 2; ++j) {
                load_row8(FO, PART, row, j, lane, f[q][j]);
                xa[q][j] = *(const f32x4*)(orow + 512 * j + 8 * lane); xb[q][j] = *(const f32x4*)(orow + 512 * j + 8 * lane + 4);
            }
        }
#pragma unroll
        for (int q = 0; q < 2; ++q)
#pragma unroll
            for (int j = 0; j < 2; ++j)
#pragma unroll
                for (int e = 0; e < 8; ++e) ss[q] += f[q][j][e] * f[q][j][e];
#pragma unroll
        for (int q = 0; q < 2; ++q) {
            const float r = rsqrtf(wave_sum(ss[q]) * (1.f / 1024.f) + EPS);
            const int row = rowa + q * NGW;
            if (row < MT) {
                float* orow = p.out + O_Y + (size_t)row * 1024;
#pragma unroll
                for (int j = 0; j < 2; ++j) {
                    const f32x4 ga = *(const f32x4*)(p.g_post_ffn + 512 * j + 8 * lane), gb = *(const f32x4*)(p.g_post_ffn + 512 * j + 8 * lane + 4);
                    f32x4 a = xa[q][j], b = xb[q][j];
                    a.x += f[q][j][0] * r * ga.x; a.y += f[q][j][1] * r * ga.y; a.z += f[q][j][2] * r * ga.z; a.w += f[q][j][3] * r * ga.w;
                    b.x += f[q][j][4] * r * gb.x; b.y += f[q][j][5] * r * gb.y; b.z += f[q][j][6] * r * gb.z; b.w += f[q][j][7] * r * gb.w;
                    *(f32x4*)(orow + 512 * j + 8 * lane) = a; *(f32x4*)(orow + 512 * j + 8 * lane + 4) = b;
                }
            }
        }
    }
}

#define XB_TMO      128
#define XB_XCNT(j)  (256  + 64 * (j))
#define XB_XSUB(j)  (1280 + 64 * (j))
#define XB_XGEN(j)  (2304 + 64 * (j))
#define XB_TOP      3328
#define XB_TOPGEN   3392
#define XCD_BAR_WORDS 3456
#define XB_SPIN_CAP (1u << 18)

__device__ __forceinline__ unsigned xb_ld(unsigned* p)              { return __hip_atomic_load(p, __ATOMIC_RELAXED, __HIP_MEMORY_SCOPE_AGENT); }
__device__ __forceinline__ unsigned xb_add(unsigned* p, unsigned v) { return __hip_atomic_fetch_add(p, v, __ATOMIC_RELAXED, __HIP_MEMORY_SCOPE_AGENT); }
__device__ __forceinline__ unsigned xb_xcc_id() { return (unsigned)__builtin_amdgcn_s_getreg((3 << 11) | 20) & 0xFu; }
#define XB_SPIN(cond, bar) do { unsigned _sp = 0; while (cond) { __builtin_amdgcn_s_sleep(1); \
    if ((++_sp & 255u) == 0u) { if (xb_ld(&(bar)[XB_TMO])) break; if (_sp > XB_SPIN_CAP) { atomicAdd(&(bar)[XB_TMO], 1u); break; } } } } while (0)

struct XcdBarrier {
    unsigned* bar; unsigned x;
    volatile LAS unsigned* st;
};

__device__ __forceinline__ XcdBarrier xcd_barrier_post(unsigned* bar, volatile LAS unsigned* st) {
    XcdBarrier b; b.bar = bar; b.x = xb_xcc_id(); b.st = st;
    if (threadIdx.x == 0) (void)xb_add(&bar[XB_XCNT(b.x)], 1u);
    return b;
}
__device__ __forceinline__ void xcd_barrier_complete(unsigned* bar, unsigned x, unsigned& nloc, unsigned& nx) {
    const unsigned G = gridDim.x * gridDim.y * gridDim.z;
    unsigned sum, cnt, mine, sp = 0u;
    for (;;) {
        sum = 0u; cnt = 0u; mine = 0u;
#pragma unroll
        for (unsigned j = 0; j < 16; ++j) { const unsigned c = xb_ld(&bar[XB_XCNT(j)]); sum += c; cnt += (c > 0u) ? 1u : 0u; mine = (j == x) ? c : mine; }
        if (sum == G) break;
        __builtin_amdgcn_s_sleep(1);
        if ((++sp & 255u) == 0u) { if (xb_ld(&bar[XB_TMO])) break; if (sp > XB_SPIN_CAP) { atomicAdd(&bar[XB_TMO], 1u); break; } }
    }
    nloc = mine > 0u ? mine : 1u; nx = cnt > 0u ? cnt : 1u;
}

__device__ __forceinline__ void xcd_barrier(const XcdBarrier& b) {
    asm volatile("s_waitcnt vmcnt(0)" ::: "memory");
    __syncthreads();
    if (threadIdx.x == 0) {
        unsigned* bar = b.bar;
        __builtin_amdgcn_s_waitcnt(0);
        unsigned nloc = b.st[0], nx = b.st[1];
        if (nloc == 0u) { xcd_barrier_complete(bar, b.x, nloc, nx); b.st[0] = nloc; b.st[1] = nx; }
        const unsigned old = xb_add(&bar[XB_XSUB(b.x)], 1u);
        const unsigned gen = old / nloc;
        if (old + 1u == (gen + 1u) * nloc) {
            __builtin_amdgcn_fence(__ATOMIC_RELEASE, "agent");
            asm volatile("s_waitcnt vmcnt(0)" ::: "memory");
            const unsigned og = xb_add(&bar[XB_TOP], 1u);
            const unsigned tg = og / nx;
            if (og + 1u == (tg + 1u) * nx) xb_add(&bar[XB_TOPGEN], 1u);
            else XB_SPIN(xb_ld(&bar[XB_TOPGEN]) == tg, bar);
            __builtin_amdgcn_fence(__ATOMIC_ACQUIRE, "agent");
            xb_add(&bar[XB_XGEN(b.x)], 1u);
            asm volatile("s_waitcnt vmcnt(0)" ::: "memory");
        } else {
            XB_SPIN(xb_ld(&bar[XB_XGEN(b.x)]) == gen, bar);
            __builtin_amdgcn_fence(__ATOMIC_ACQUIRE, "agent");
            asm volatile("s_waitcnt vmcnt(0)" ::: "memory");
        }
    }
    __syncthreads();
}


__global__ void __launch_bounds__(512, 2) mega_fwd(Params p) {
    extern __shared__ __attribute__((aligned(16))) unsigned char lds_raw[];
    LAS unsigned char* lds = (LAS unsigned char*)lds_raw;
    cg::grid_group grid = cg::this_grid();
#define GRID_SYNC() xcd_barrier(xbar)
    const int G = gridDim.x, bx = blockIdx.x, NGW = G * 8, NT = G * 512;
#define IDS() int tid = threadIdx.x; asm volatile("" : "+v"(tid)); const int lane = tid & 63, wave = __builtin_amdgcn_readfirstlane(tid >> 6), gw = bx * 8 + wave, gtid = bx * 512 + tid; (void)lane; (void)gw; (void)gtid
    unsigned char* ws = p.ws;
    if (threadIdx.x < 16) ((volatile LAS unsigned*)(lds + 131072))[threadIdx.x] = 0u;
    __syncthreads();
    const XcdBarrier xbar = xcd_barrier_post((unsigned*)(p.ws + WS_BAR), (volatile LAS unsigned*)(lds + 131072));
    grid.sync();

#ifndef SK_P0
    { IDS(); phase0(p, lds, gw, NGW, lane, wave); }
#endif
    GRID_SYNC();

    {
        pg8::Sched S;
        S.A0 = (const char*)(ws + WS_XN); S.B0 = (const char*)(ws + WS_WIN); S.dAj = (long)WS_MN - (long)WS_XN; S.dBj = (long)WS_WKV - (long)WS_WIN; S.dAb = 0; S.dBb = 0;
        S.nM0 = 68; S.nN0 = 14; S.nt0 = 68 * 14; S.nM1 = 8; S.nN1 = 4; S.nt1 = 32; S.nbr = 1; S.G = G; S.c = bx; S.ktiles = 16; S.split = 0; S.nta = 0; S.ntb = 0; S.tstep = (size_t)256 * 1024 * 2;
        EpiP1 E;
        E.U = (bf16_t*)(ws + WS_U); E.QD = (bf16_t*)(ws + WS_QD); E.KI = (bf16_t*)(ws + WS_KI); E.KE = (bf16_t*)(ws + WS_KE); E.VV = (bf16_t*)(ws + WS_VV); E.HGT = (bf16_t*)(ws + WS_HGT); E.MQ = (bf16_t*)(ws + WS_MQ);
        E.KB = (bf16_t*)(ws + WS_KB); E.VT = (bf16_t*)(ws + WS_VT); E.DEC = (float*)(ws + WS_DEC); E.mk = p.out + O_MK; E.mv = p.out + O_MV; E.lbl = p.lb_logits;
#ifndef SK_P1
        pg8::gemm_phase<EpiP1>(lds, 1024, S, E);
        if (G == 256 && bx >= 216) { IDS(); weight_copies(p, lds, 3840, 5120, (bx - 216) * 8 + wave, 40 * 8, lane, wave); }
        else if (G != 256 && bx == 0) { IDS(); weight_copies(p, lds, 3840, 5120, wave, 8, lane, wave); }
#endif
    }
    GRID_SYNC();

#ifndef SK_ATT
    { IDS(); attn_sample_block(p, lds, wave, lane); }
    { IDS(); attn_prompt_block(p, lds, wave, lane, tid); }
#endif
#ifndef SK_CONV
    { IDS(); conv_prompt_block(p, lds, wave, lane, tid); }
    { IDS(); conv_phase(p, lds, wave, gw, NGW, lane); }
#endif
    { IDS(); convstate_phase(p, gtid, NT); }
#ifndef SK_HG1
    { IDS(); hg1_phase(p, gw, NGW, lane); }
#endif
    GRID_SYNC();
    { IDS(); hg2_phase(p, gtid, NT); }
    GRID_SYNC();
#ifndef SK_HG3
    { IDS(); hg3_phase(p, gw, NGW, lane); }
#endif
    GRID_SYNC();

    {
        pg8::Sched S;
        S.A0 = (const char*)(ws + WS_XN); S.B0 = (const char*)(ws + WS_WIN + (size_t)NPROJ * 1024 * 2); S.dAj = 0; S.dBj = 0; S.dAb = 0; S.dBb = 0;
        S.nM0 = 68; S.nN0 = 12; S.nt0 = 68 * 12; S.nM1 = 1; S.nN1 = 1; S.nt1 = 0; S.nbr = 1; S.G = G; S.c = bx; S.ktiles = 16; S.split = 0; S.nta = 0; S.ntb = 0; S.tstep = (size_t)256 * 1024 * 2;
        EpiPlain<3> E; E.O = (bf16_t*)(ws + WS_U); E.ldc = NGATE;
        pg8::gemm_phase<EpiPlain<3>>(lds, 1024, S, E);
        if (G == 256 && bx >= 48) { IDS(); weight_copies(p, lds, 5120, 9344, (bx - 48) * 8 + wave, 208 * 8, lane, wave); }
        else if (G != 256 && bx == 0) { IDS(); weight_copies(p, lds, 5120, 9344, wave, 8, lane, wave); }
    }
    GRID_SYNC();
    {
        pg8::Sched S;
        S.A0 = (const char*)(ws + WS_C); S.B0 = (const char*)(ws + WS_W3); S.dAj = 0; S.dBj = 0; S.dAb = (long)SZ_ACT512; S.dBb = (long)1024 * 512 * 2;
        S.nM0 = 68; S.nN0 = 4; S.nt0 = 68 * 4; S.nM1 = 1; S.nN1 = 1; S.nt1 = 0; S.nbr = 3; S.G = G; S.c = bx; S.ktiles = 8; S.split = 0; S.nta = 0; S.ntb = 0; S.tstep = (size_t)256 * 512 * 2;
        EpiMerge E; E.MG = (bf16_t*)(ws + WS_KB); E.GG = (const bf16_t*)(ws + WS_U);
        pg8::gemm_phase<EpiMerge, true>(lds, 512, S, E);
    }
    GRID_SYNC();
    {
        pg8::Sched S;
        S.A0 = (const char*)(ws + WS_KB); S.B0 = (const char*)(ws + WS_WO); S.dAj = 0; S.dBj = 0; S.dAb = 0; S.dBb = 0;
        S.nM0 = 64; S.nN0 = 4; S.nt0 = 64 * 4; S.nM1 = 1; S.nN1 = 1; S.nt1 = 0; S.nbr = 1; S.G = G; S.c = bx; S.ktiles = 16; S.split = 1; S.nta = 4; S.ntb = 4; S.tstep = (size_t)256 * 1024 * 2;
        EpiPlainSplit E; E.O = (bf16_t*)(ws + WS_VT); E.P = (float*)(ws + WS_PART);
        pg8::gemm_phase<EpiPlainSplit>(lds, 1024, S, E);
    }
    GRID_SYNC();
    { IDS(); rowpass1(p, gw, NGW, lane); }
    GRID_SYNC();
    {
        pg8::Sched S;
        S.A0 = (const char*)(ws + WS_XN); S.B0 = (const char*)(ws + WS_WGU); S.dAj = 0; S.dBj = 0; S.dAb = 0; S.dBb = 0;
        S.nM0 = 68; S.nN0 = 22; S.nt0 = 68 * 22; S.nM1 = 1; S.nN1 = 1; S.nt1 = 0; S.nbr = 1; S.G = G; S.c = bx; S.ktiles = 16; S.split = 0; S.nta = 0; S.ntb = 0; S.tstep = (size_t)256 * 1024 * 2;
        EpiSwiglu E; E.F = (bf16_t*)(ws + WS_U);
        pg8::gemm_phase<EpiSwiglu>(lds, 1024, S, E);
    }
    GRID_SYNC();
    {
        pg8::Sched S;
        S.A0 = (const char*)(ws + WS_U); S.B0 = (const char*)(ws + WS_WD); S.dAj = 0; S.dBj = 0; S.dAb = 0; S.dBb = 0;
        S.nM0 = 64; S.nN0 = 4; S.nt0 = 64 * 4; S.nM1 = 1; S.nN1 = 1; S.nt1 = 0; S.nbr = 1; S.G = G; S.c = bx; S.ktiles = 44; S.split = 1; S.nta = 12; S.ntb = 10; S.tstep = (size_t)256 * DFF * 2;
        EpiPlainSplit E; E.O = (bf16_t*)(ws + WS_KB); E.P = (float*)(ws + WS_PART);
        pg8::gemm_phase<EpiPlainSplit>(lds, DFF, S, E);
    }
    GRID_SYNC();
    { IDS(); rowpass2(p, gw, NGW, lane); }
}

extern "C" void kernel_launch(void* const* d_in, const int* in_sizes, int n_in, void* d_out, int out_size, void* d_ws, size_t ws_size, hipStream_t stream) {
    static int grid = 0;
    if (grid == 0) {
        if (n_in != 27 || ws_size < WS_END) { fprintf(stderr, "kernel_launch: need 27 inputs and %zu bytes of workspace; got %d, %zu\n", (size_t)WS_END, n_in, ws_size); grid = -1; return; }
        int dev = 0, cus = 0, per_cu = 0;
        hipGetDevice(&dev);
        hipDeviceGetAttribute(&cus, hipDeviceAttributeMultiprocessorCount, dev);
        if (hipFuncSetAttribute((const void*)mega_fwd, hipFuncAttributeMaxDynamicSharedMemorySize, LDS_BYTES) != hipSuccess) { fprintf(stderr, "kernel_launch: hipFuncSetAttribute failed\n"); grid = -1; return; }
        if (hipOccupancyMaxActiveBlocksPerMultiprocessor(&per_cu, (const void*)mega_fwd, 512, LDS_BYTES) != hipSuccess || per_cu < 1) { fprintf(stderr, "kernel_launch: occupancy query failed (%d)\n", per_cu); per_cu = 1; }
        (void)hipGetLastError();
        grid = cus;
        if (grid <= 0) grid = 256;
    }
    if (grid < 0) return;
    if (hipMemsetAsync((char*)d_ws + WS_BAR, 0, 16384, stream) != hipSuccess) { fprintf(stderr, "kernel_launch: memset failed\n"); return; }
    Params p{};
    const float* const* in = (const float* const*)d_in;
    p.x_prompt = in[0]; p.x_sample = in[1]; p.mem_prompt = in[2]; p.state_conv = in[3]; p.state_hgrn = in[4]; p.cache_k = in[5]; p.cache_v = in[6];
    p.g_pre_mix = in[7]; p.g_post_mix = in[8]; p.g_pre_ffn = in[9]; p.g_post_ffn = in[10];
    p.w_in = in[11]; p.conv_w = in[12]; p.conv_b = in[13]; p.ln_g = in[14]; p.ln_b = in[15]; p.w_conv_out = in[16]; p.lb_logits = in[17]; p.hg_norm_g = in[18]; p.w_hg_out = in[19];
    p.mem_norm_g = in[20]; p.w_mem_kv = in[21]; p.w_mem_out = in[22]; p.w_out = in[23]; p.w_gate = in[24]; p.w_up = in[25]; p.w_down = in[26];
    p.out = (float*)d_out; p.ws = (unsigned char*)d_ws;
    void* args[] = {&p};
    hipError_t e = hipLaunchCooperativeKernel((const void*)mega_fwd, dim3(grid), dim3(512), args, LDS_BYTES, stream);
    if (e != hipSuccess) fprintf(stderr, "kernel_launch: cooperative launch failed: %s (grid %d)\n", hipGetErrorString(e), grid);
}
```
